# Optimizing an MI355X kernel written in HIP

```python
import math
import jax, jax.numpy as jnp
from jax import lax
import numpy as np

D_MODEL = 1024
BATCH = 32
SEQ = 2048
DEPTH = 4

GRID_W = 64
ROPE_THETA = 10000.0
Q_BLOCK = 128
EPS = 1e-6

MLA_HEADS = 16
MLA_NOPE = 64
MLA_ROPE = 32
MLA_QK = MLA_NOPE + MLA_ROPE
MLA_V = 64
Q_LORA = 384
KV_LORA = 256

GQA_HEADS = 16
GQA_KV_HEADS = 4
GQA_GROUP = GQA_HEADS // GQA_KV_HEADS
GQA_HD = D_MODEL // GQA_HEADS

D_FF = ((8 * D_MODEL + 3 * 256 - 1) // (3 * 256)) * 256

N_MIXERS = 2
N_MLA_LAYERS = (DEPTH + 1) // 2
N_GQA_LAYERS = DEPTH // 2

kernel_name = "interleaved_mla_gqa_axial_swiglu_encoder"


def rmsnorm(x, g):
    xf = x.astype(jnp.float32)
    y = xf * lax.rsqrt(jnp.mean(xf * xf, axis=-1, keepdims=True) + EPS)
    return (y * g.astype(jnp.float32)).astype(x.dtype)


def grid_positions(seq_len):
    rows = seq_len // GRID_W
    row = jnp.repeat(jnp.arange(rows, dtype=jnp.int32), GRID_W)
    col = jnp.tile(jnp.arange(GRID_W, dtype=jnp.int32), rows)
    return row, col


def rope_table(pos, dim):
    inv = ROPE_THETA ** (-jnp.arange(0, dim, 2, dtype=jnp.float32) / dim)
    ang = pos.astype(jnp.float32)[:, None] * inv[None, :]
    return jnp.cos(ang), jnp.sin(ang)


def axial_tables(row, col, rot_dim):
    half = rot_dim // 2
    cr, sr = rope_table(row, half)
    cc, sc = rope_table(col, half)
    return (cr, sr, cc, sc)


def rope_1d(x, cos, sin):
    d2 = x.shape[-1] // 2
    x1, x2 = x[..., :d2], x[..., d2:]
    c = cos[:, None, :]
    s = sin[:, None, :]
    return jnp.concatenate([x1 * c - x2 * s, x2 * c + x1 * s], axis=-1)


def axial_rope(x, tabs):
    cr, sr, cc, sc = tabs
    half = x.shape[-1] // 2
    xf = x.astype(jnp.float32)
    out = jnp.concatenate([rope_1d(xf[..., :half], cr, sr),
                           rope_1d(xf[..., half:], cc, sc)], axis=-1)
    return out.astype(x.dtype)


def blocked_attention(q, k, v, scale):
    B, S, HKV, G, Dk = q.shape
    nb = S // Q_BLOCK
    qb = q.reshape(B, nb, Q_BLOCK, HKV, G, Dk).transpose(1, 0, 2, 3, 4, 5)

    def one_block(q_blk):
        s = jnp.einsum('bqkgd,bskd->bkgqs', q_blk, k,
                       preferred_element_type=jnp.float32) * scale
        p = jax.nn.softmax(s, axis=-1).astype(v.dtype)
        return jnp.einsum('bkgqs,bskd->bqkgd', p, v)

    out = lax.map(one_block, qb)
    Dv = v.shape[-1]
    return out.transpose(1, 0, 2, 3, 4, 5).reshape(B, S, HKV * G, Dv)


def mla_mixer(h, w_in, q_lora_norm, w_uq, kv_lora_norm, w_ukv, q_norm, k_norm, w_o, tabs):
    B, S, _ = h.shape
    lat = h @ w_in
    c_q = rmsnorm(lat[..., :Q_LORA], q_lora_norm)
    c_kv = rmsnorm(lat[..., Q_LORA:Q_LORA + KV_LORA], kv_lora_norm)
    k_r = lat[..., Q_LORA + KV_LORA:][:, :, None, :]

    q = (c_q @ w_uq).reshape(B, S, MLA_HEADS, MLA_QK)
    kv = (c_kv @ w_ukv).reshape(B, S, MLA_HEADS, MLA_NOPE + MLA_V)
    k_nope, v = kv[..., :MLA_NOPE], kv[..., MLA_NOPE:]

    q_nope = rmsnorm(q[..., :MLA_NOPE], q_norm[:MLA_NOPE])
    q_rope = axial_rope(rmsnorm(q[..., MLA_NOPE:], q_norm[MLA_NOPE:]), tabs)
    k_nope = rmsnorm(k_nope, k_norm[:MLA_NOPE])
    k_rope = axial_rope(rmsnorm(k_r, k_norm[MLA_NOPE:]), tabs)
    k_rope = jnp.broadcast_to(k_rope, (B, S, MLA_HEADS, MLA_ROPE))

    q_full = jnp.concatenate([q_nope, q_rope], axis=-1)[:, :, :, None, :]
    k_full = jnp.concatenate([k_nope, k_rope], axis=-1)
    o = blocked_attention(q_full, k_full, v, MLA_QK ** -0.5)
    return o.reshape(B, S, MLA_HEADS * MLA_V) @ w_o


def gqa_mixer(h, w_qkv, q_norm, k_norm, w_o, tabs):
    B, S, _ = h.shape
    qkv = h @ w_qkv
    nq = GQA_HEADS * GQA_HD
    nk = GQA_KV_HEADS * GQA_HD
    q = qkv[..., :nq].reshape(B, S, GQA_HEADS, GQA_HD)
    k = qkv[..., nq:nq + nk].reshape(B, S, GQA_KV_HEADS, GQA_HD)
    v = qkv[..., nq + nk:].reshape(B, S, GQA_KV_HEADS, GQA_HD)
    q = axial_rope(rmsnorm(q, q_norm), tabs)
    k = axial_rope(rmsnorm(k, k_norm), tabs)
    q = q.reshape(B, S, GQA_KV_HEADS, GQA_GROUP, GQA_HD)
    o = blocked_attention(q, k, v, GQA_HD ** -0.5)
    return o.reshape(B, S, GQA_HEADS * GQA_HD) @ w_o


def swiglu(h, w_gate_up, w_down):
    gu = h @ w_gate_up
    g, u = gu[..., :D_FF], gu[..., D_FF:]
    return (jax.nn.silu(g) * u) @ w_down


def setup_inputs(seed: int = 0) -> dict:
    key = jax.random.key(seed)
    ks = jax.random.split(key, 20)

    def w(k, shape, fan_in):
        return jax.random.normal(k, shape, jnp.float32) * (fan_in ** -0.5)

    def gain(k, shape):
        return 1.0 + 0.02 * jax.random.normal(k, shape, jnp.float32)

    LA, LB, L = N_MLA_LAYERS, N_GQA_LAYERS, DEPTH
    return {
        "x": jax.random.normal(ks[0], (BATCH, SEQ, D_MODEL), jnp.float32),
        "mla_norm": gain(ks[1], (LA, D_MODEL)),
        "mla_w_in": w(ks[2], (LA, D_MODEL, Q_LORA + KV_LORA + MLA_ROPE), D_MODEL),
        "mla_q_lora_norm": gain(ks[3], (LA, Q_LORA)),
        "mla_w_uq": w(ks[4], (LA, Q_LORA, MLA_HEADS * MLA_QK), Q_LORA),
        "mla_kv_lora_norm": gain(ks[5], (LA, KV_LORA)),
        "mla_w_ukv": w(ks[6], (LA, KV_LORA, MLA_HEADS * (MLA_NOPE + MLA_V)), KV_LORA),
        "mla_q_norm": gain(ks[7], (LA, MLA_QK)),
        "mla_k_norm": gain(ks[8], (LA, MLA_QK)),
        "mla_w_o": w(ks[9], (LA, MLA_HEADS * MLA_V, D_MODEL), MLA_HEADS * MLA_V),
        "gqa_norm": gain(ks[10], (LB, D_MODEL)),
        "gqa_w_qkv": w(ks[11], (LB, D_MODEL, (GQA_HEADS + 2 * GQA_KV_HEADS) * GQA_HD), D_MODEL),
        "gqa_q_norm": gain(ks[12], (LB, GQA_HD)),
        "gqa_k_norm": gain(ks[13], (LB, GQA_HD)),
        "gqa_w_o": w(ks[14], (LB, GQA_HEADS * GQA_HD, D_MODEL), GQA_HEADS * GQA_HD),
        "ffn_norm": gain(ks[15], (L, D_MODEL)),
        "ffn_w_gate_up": w(ks[16], (L, D_MODEL, 2 * D_FF), D_MODEL),
        "ffn_w_down": w(ks[17], (L, D_FF, D_MODEL), D_FF),
    }


def reference(x, mla_norm, mla_w_in, mla_q_lora_norm, mla_w_uq, mla_kv_lora_norm,
              mla_w_ukv, mla_q_norm, mla_k_norm, mla_w_o, gqa_norm, gqa_w_qkv,
              gqa_q_norm, gqa_k_norm, gqa_w_o, ffn_norm, ffn_w_gate_up, ffn_w_down):
    S = x.shape[1]
    row, col = grid_positions(S)
    mla_tabs = axial_tables(row, col, MLA_ROPE)
    gqa_tabs = axial_tables(row, col, GQA_HD)

    for i in range(DEPTH):
        j = i // N_MIXERS
        if i % N_MIXERS == 0:
            h = rmsnorm(x, mla_norm[j])
            x = x + mla_mixer(h, mla_w_in[j], mla_q_lora_norm[j], mla_w_uq[j],
                              mla_kv_lora_norm[j], mla_w_ukv[j], mla_q_norm[j],
                              mla_k_norm[j], mla_w_o[j], mla_tabs)
        else:
            h = rmsnorm(x, gqa_norm[j])
            x = x + gqa_mixer(h, gqa_w_qkv[j], gqa_q_norm[j], gqa_k_norm[j],
                              gqa_w_o[j], gqa_tabs)
        h = rmsnorm(x, ffn_norm[i])
        x = x + swiglu(h, ffn_w_gate_up[i], ffn_w_down[i])
    return x
```

```cpp
#include <hip/hip_runtime.h>
#include <hip/hip_cooperative_groups.h>
#include <cstdio>
#include <cstdint>
namespace cg = cooperative_groups;

#define LAS __attribute__((address_space(3)))
typedef unsigned short bf16_t;
typedef short bf16x8 __attribute__((ext_vector_type(8)));
typedef short s16x4 __attribute__((ext_vector_type(4)));
typedef float f32x4 __attribute__((ext_vector_type(4)));
typedef float f32x2 __attribute__((ext_vector_type(2)));
typedef float f32x16 __attribute__((ext_vector_type(16)));
typedef unsigned u32x4 __attribute__((ext_vector_type(4)));
typedef unsigned u32x2 __attribute__((ext_vector_type(2)));
typedef __bf16 bf16x2_t __attribute__((ext_vector_type(2)));

constexpr int T = 65536, DM = 1024, SEQ = 2048, NB = 32;
constexpr int QL = 384, KVL = 256, DFF = 2816;
constexpr float EPS = 1e-6f;
constexpr int NWAVES = 8;
constexpr float CQ_MLA = 0.10206207261596577f * 1.4426950408889634f, CQ_GQA = 0.125f * 1.4426950408889634f;

constexpr size_t MiB = 1u << 20;
constexpr size_t WS_TABM = 0, WS_TABG = 4096;
constexpr size_t WS_SS = 1 * MiB;
constexpr size_t WS_SSL = 5 * MiB;
constexpr size_t WS_KR = 9 * MiB;
constexpr size_t WS_W = 13 * MiB;
constexpr size_t WS_XB = 101 * MiB;
constexpr size_t WS_AO = 229 * MiB;
constexpr size_t WS_B = 357 * MiB;
constexpr size_t WS_KV = 709 * MiB;
constexpr size_t WS_END = 965 * MiB;
constexpr size_t W_IN_E = 768 * 1024, W_UQ_E = 1536 * 384, W_UKV_E = 2048 * 256, W_O_E = 1024 * 1024;
constexpr size_t W_MLA_E = W_IN_E + W_UQ_E + W_UKV_E + W_O_E;
constexpr size_t W_QKV_E = 1536 * 1024, W_GQA_E = W_QKV_E + W_O_E;
constexpr size_t W_GU_E = 5632 * 1024, W_DN_E = 1024 * 2816, W_FFN_E = W_GU_E + W_DN_E;
constexpr size_t WOFF_MLA = 0, WOFF_GQA = 2 * W_MLA_E, WOFF_FFN = WOFF_GQA + 2 * W_GQA_E;
static_assert((WOFF_FFN + 4 * W_FFN_E) * 2 <= 88 * MiB, "weights fit");

__device__ __forceinline__ unsigned cvtpk(float lo, float hi) { f32x2 v = {lo, hi}; bf16x2_t b = __builtin_convertvector(v, bf16x2_t); return __builtin_bit_cast(unsigned, b); }
__device__ __forceinline__ u32x4 pack8(f32x4 a, f32x4 b) { u32x4 w; w.x = cvtpk(a[0], a[1]); w.y = cvtpk(a[2], a[3]); w.z = cvtpk(b[0], b[1]); w.w = cvtpk(b[2], b[3]); return w; }
__device__ __forceinline__ u32x2 pack4(f32x4 a) { u32x2 w; w.x = cvtpk(a[0], a[1]); w.y = cvtpk(a[2], a[3]); return w; }
__device__ __forceinline__ float dot4(f32x4 a) { return (a[0] * a[0] + a[1] * a[1]) + (a[2] * a[2] + a[3] * a[3]); }
__device__ __forceinline__ float rsq(float x) { return __builtin_amdgcn_rsqf(x); }
__device__ __forceinline__ float red_fq(float s) { s += __shfl_xor(s, 16); s += __shfl_xor(s, 32); return s; }
__device__ __forceinline__ float sum16(const float* p) { const f32x4* q = (const f32x4*)p; f32x4 a = q[0] + q[1] + q[2] + q[3]; return (a[0] + a[1]) + (a[2] + a[3]); }


struct RsSrc { const float* p; int off; int two; float inv; };
__device__ __forceinline__ void rs_load(const RsSrc& R, int pm, int tid, f32x4& r0, f32x4& r1) {
    const int row = pm * 256 + (tid >> 1), part = tid & 1;
    const float* b = R.p + (size_t)row * 16 + R.off + (R.two ? 8 : 4) * part;
    r0 = *(const f32x4*)b; r1 = (f32x4){0.f, 0.f, 0.f, 0.f}; if (R.two) r1 = *(const f32x4*)(b + 4);
}
__device__ __forceinline__ void rs_store(const RsSrc& R, LAS float* rs, int tid, f32x4 r0, f32x4 r1) {
    const f32x4 a = r0 + r1; float s = (a[0] + a[1]) + (a[2] + a[3]); s += __shfl_xor(s, 1);
    if ((tid & 1) == 0) rs[tid >> 1] = rsq(s * R.inv + EPS);
}
namespace pg8 {
constexpr int BM = 256, BK = 64, HALF = 128, HTB = HALF * BK * 2, STAGE_BYTES = 8 * HTB, NXCD = 8, WGM = 8;
__host__ __device__ __forceinline__ int lds_byte(int r, int c) { const int st = (r >> 4) * 2 + (c >> 5), rr = r & 15, cc = c & 31, ob = rr * 64 + cc * 2; return st * 1024 + (ob ^ (((ob >> 9) & 1) << 5)); }
__host__ __device__ __forceinline__ void stage_rc(int b, int& R, int& C) { const int st = b / 1024, sb = b % 1024, swz = sb ^ (((sb >> 9) & 1) << 5); R = (st >> 1) * 16 + swz / 64; C = (st & 1) * 32 + (swz % 64) / 2; }
struct Unit { int pm, pn; };
struct StaticOrder {
    int nM, nN, nwg, G, c;
    __device__ void init(int M, int N, int G_, int c_) { nM = M / BM; nN = N / BM; nwg = nM * nN; G = G_; c = c_; }
    __device__ bool next(int i, Unit& u) const {
        const long L = (long)i * G + c; if (L >= nwg) return false;
        int wgid = (int)L; { const int q = nwg / NXCD, r = nwg % NXCD, xcd = wgid % NXCD, off = wgid / NXCD; wgid = (xcd < r ? xcd * (q + 1) : r * (q + 1) + (xcd - r) * q) + off; }
        const int nig = WGM * nN, gid = wgid / nig, fm = gid * WGM, gsz = (nM - fm) < WGM ? (nM - fm) : WGM;
        u.pm = fm + ((wgid % nig) % gsz); u.pn = (wgid % nig) / gsz; return true;
    }
};
template <class Epi>
__device__ __forceinline__ void gemm_phase(LAS unsigned char* lds, const bf16_t* A, const int lda, const bf16_t* Bt, const int M, const int N, const int K, const int G, const int cidx, const Epi& E) {
    int tid = threadIdx.x; asm volatile("" : "+v"(tid));
    const int wid = __builtin_amdgcn_readfirstlane(tid >> 6), lane = tid & 63, wr = wid >> 2, wc = wid & 3, fr = lane & 15, fq = lane >> 4;
    const int nt = K / BK;
    StaticOrder S; S.init(M, N, G, cidx);
    unsigned voffA[2], voffB[2];
#pragma unroll
    for (int i = 0; i < 2; ++i) { int R, C; stage_rc(tid * 16 + i * 8192, R, C); voffA[i] = (unsigned)(tid * 16 + i * 8192); voffB[i] = voffA[i]; (void)R; (void)C; }
    const size_t kstep = (size_t)HTB, kstepB = (size_t)HTB;
    const size_t hA = (size_t)(lda / BK) * HTB, hB = (size_t)(K / BK) * HTB;
    const size_t tA = 2 * hA, tB = 2 * hB;
    const unsigned ldsw = (unsigned)wid * 1024u;
    const int aoff = lds_byte(wr * 64 + fr, fq * 8), boff = lds_byte(wc * 32 + fr, fq * 8);
    LAS float* rsl = (LAS float*)(lds + STAGE_BYTES + 256);
#define PG8_SA(b, h) (((b) * 2 + (h)) * HTB)
#define PG8_SB(b, h) ((4 + (b) * 2 + (h)) * HTB)
#define PG8_STAGE(bufoff, gbase, voff) do { _Pragma("unroll") for (int _i = 0; _i < 2; ++_i) \
        __builtin_amdgcn_global_load_lds((const unsigned*)((const char*)(gbase) + (voff)[_i]), (LAS unsigned*)(lds + (bufoff) + ldsw + _i * 8192), 16, 0, 0); } while (0)
#define PG8_LDA(dst, b, h) do { _Pragma("unroll") for (int m = 0; m < 4; ++m) _Pragma("unroll") for (int k = 0; k < 2; ++k) dst[m][k] = *(const LAS bf16x8*)(lds + PG8_SA(b, h) + aoff + m * 2048 + k * 1024); } while (0)
#define PG8_LDB(dst, b, h) do { _Pragma("unroll") for (int n = 0; n < 2; ++n) _Pragma("unroll") for (int k = 0; k < 2; ++k) dst[n][k] = *(const LAS bf16x8*)(lds + PG8_SB(b, h) + boff + n * 2048 + k * 1024); } while (0)
#define PG8_MMA(ai, bj, At, Bt_) do { __builtin_amdgcn_s_setprio(1); _Pragma("unroll") for (int m = 0; m < 4; ++m) _Pragma("unroll") for (int n = 0; n < 2; ++n) _Pragma("unroll") for (int k = 0; k < 2; ++k) \
        acc[ai][bj][m][n] = __builtin_amdgcn_mfma_f32_16x16x32_bf16(Bt_[n][k], At[m][k], acc[ai][bj][m][n], 0, 0, 0); __builtin_amdgcn_s_setprio(0); } while (0)
#define PG8_WAIT_V(n) asm volatile("s_waitcnt vmcnt(" #n ")" ::: "memory")
#define PG8_WAIT_L(n) asm volatile("s_waitcnt lgkmcnt(" #n ")" ::: "memory")
#define PG8_BAR __builtin_amdgcn_s_barrier()
#define PG8_SCHED __builtin_amdgcn_sched_barrier(0)
    Unit cur, nxt; int ui = 0;
    if (!S.next(0, cur)) return;
    if constexpr (Epi::NEEDS_RS) { f32x4 r0_, r1_; rs_load(E.rsrc, cur.pm, tid, r0_, r1_); rs_store(E.rsrc, rsl, tid, r0_, r1_); }
    f32x4 acc[2][2][4][2];
#pragma unroll
    for (int a = 0; a < 2; ++a)
#pragma unroll
        for (int b = 0; b < 2; ++b)
#pragma unroll
            for (int m = 0; m < 4; ++m)
#pragma unroll
                for (int n = 0; n < 2; ++n) acc[a][b][m][n] = (f32x4){0.f, 0.f, 0.f, 0.f};
    bf16x8 At[4][2], B0[2][2], B1[2][2];
    const char* cA = (const char*)A + (size_t)cur.pm * tA; const char* cB = (const char*)Bt + (size_t)cur.pn * tB;
    PG8_STAGE(PG8_SB(0, 0), cB, voffB); PG8_STAGE(PG8_SB(0, 1), cB + hB, voffB); PG8_STAGE(PG8_SA(0, 0), cA, voffA); PG8_STAGE(PG8_SA(0, 1), cA + hA, voffA);
    if (wr == 1) PG8_BAR;
    PG8_WAIT_V(2); PG8_BAR;
    PG8_STAGE(PG8_SB(1, 0), cB + kstepB, voffB); PG8_STAGE(PG8_SA(1, 0), cA + kstep, voffA); PG8_STAGE(PG8_SB(1, 1), cB + hB + kstepB, voffB);
    PG8_WAIT_V(6); PG8_BAR;
    for (;;) {
        const bool has_next = S.next(ui + 1, nxt);
        const char* nA = has_next ? (const char*)A + (size_t)nxt.pm * tA : cA; const char* nB = has_next ? (const char*)Bt + (size_t)nxt.pn * tB : cB;
#pragma nounroll
        for (int t = 0; t < nt; t += 2) {
            const bool last = (t == nt - 2);
            const char* a1 = cA + (size_t)(t + 1) * kstep;
            const char* a2 = last ? nA : cA + (size_t)(t + 2) * kstep; const char* b2 = last ? nB : cB + (size_t)(t + 2) * kstepB;
            const char* a3 = a2 + kstep; const char* b3 = b2 + kstepB;
            PG8_LDB(B0, 0, 0); PG8_LDB(B1, 0, 1); PG8_SCHED; PG8_LDA(At, 0, 0); PG8_STAGE(PG8_SA(1, 1), a1 + hA, voffA);
            PG8_WAIT_V(8); PG8_WAIT_L(0); PG8_BAR; PG8_MMA(0, 0, At, B0); PG8_MMA(0, 1, At, B1); PG8_BAR; PG8_SCHED;
            PG8_LDA(At, 0, 1); PG8_STAGE(PG8_SB(0, 0), b2, voffB); PG8_STAGE(PG8_SB(0, 1), b2 + hB, voffB); PG8_STAGE(PG8_SA(0, 0), a2, voffA);
            PG8_WAIT_V(8); PG8_WAIT_L(0); PG8_BAR; PG8_MMA(1, 0, At, B0); PG8_MMA(1, 1, At, B1); PG8_BAR; PG8_SCHED;
            PG8_LDB(B0, 1, 0); PG8_LDB(B1, 1, 1); PG8_SCHED; PG8_LDA(At, 1, 0); PG8_STAGE(PG8_SA(0, 1), a2 + hA, voffA);
            PG8_WAIT_V(8); PG8_WAIT_L(0); PG8_BAR; PG8_MMA(0, 0, At, B0); PG8_MMA(0, 1, At, B1); PG8_BAR; PG8_SCHED;
            PG8_LDA(At, 1, 1); PG8_STAGE(PG8_SB(1, 0), b3, voffB); PG8_STAGE(PG8_SB(1, 1), b3 + hB, voffB); PG8_STAGE(PG8_SA(1, 0), a3, voffA);
            PG8_WAIT_V(8); PG8_WAIT_L(0); PG8_BAR; PG8_MMA(1, 0, At, B0); PG8_MMA(1, 1, At, B1); PG8_BAR; PG8_SCHED;
        }
        const int t_ = wid * 64 + fq * 16 + fr;
        if (wr == 0) PG8_BAR;
        f32x4 rs0, rs1; if constexpr (Epi::NEEDS_RS) { if (has_next) rs_load(E.rsrc, nxt.pm, t_, rs0, rs1); }
        E(acc, cur.pm, cur.pn, wr, wc, fr, fq, rsl + (ui & 1) * 256);
        if constexpr (Epi::NEEDS_RS) { if (has_next) rs_store(E.rsrc, rsl + ((ui + 1) & 1) * 256, t_, rs0, rs1); }
        if (!has_next) break;
#pragma unroll
        for (int a = 0; a < 2; ++a)
#pragma unroll
            for (int b = 0; b < 2; ++b)
#pragma unroll
                for (int m = 0; m < 4; ++m)
#pragma unroll
                    for (int n = 0; n < 2; ++n) acc[a][b][m][n] = (f32x4){0.f, 0.f, 0.f, 0.f};
        cur = nxt; cA = nA; cB = nB; ++ui;
        if (wr == 1) PG8_BAR;
    }
    PG8_WAIT_V(0);
    PG8_BAR;
#undef PG8_SA
#undef PG8_SB
#undef PG8_STAGE
#undef PG8_LDA
#undef PG8_LDB
#undef PG8_MMA
#undef PG8_WAIT_V
#undef PG8_WAIT_L
#undef PG8_BAR
#undef PG8_SCHED
}
}

__device__ __forceinline__ size_t tm_off(int row, int col, int ld) { return ((size_t)(row >> 7) * (ld >> 6) + (col >> 6)) * 8192 + (pg8::lds_byte(row & 127, col & 56) >> 1) + (col & 7); }

enum { TY_S8 = 0, TY_WIN = 1, TY_WUQ = 2, TY_GQKV = 3, TY_GU = 4 };
__device__ __forceinline__ int pos_s8(int c) { const int g = c >> 6, pn = g >> 2, wc = g & 3, el = c & 63, bj = el >> 5, fq = (el >> 3) & 3, n = (el >> 2) & 1, e = el & 3; return 256 * pn + 128 * bj + 32 * wc + 16 * n + 4 * fq + e; }
__device__ __forceinline__ int dstrow(int type, int c) {
    switch (type) {
    case TY_WIN: {
        if (c < 640) return pos_s8(c);
        const int kc = c - 640, rc = kc >> 4, bj = (kc >> 3) & 1, idx = kc & 7, n = idx >> 2, e = idx & 3;
        return 512 + 128 * bj + 64 + 16 * n + 4 * rc + e; }
    case TY_WUQ: {
        const int h = c / 96, d = c - 96 * h;
        if (d < 64) return pos_s8(64 * h + d);
        const int rd = d - 64, tile = 4 + (h >> 3), wc = (h & 7) >> 1, bj = h & 1, rc = rd >> 4, n = (rd >> 3) & 1, idx = rd & 7, fq = 2 * rc + (idx >> 2), e = idx & 3;
        return 256 * tile + 128 * bj + 32 * wc + 16 * n + 4 * fq + e; }
    case TY_GQKV: {
        const int g = c >> 6;
        if (g >= 20) return pos_s8(c);
        const int pn = g >> 2, wc = g & 3, el = c & 63, rc = el >> 5, bj = (el >> 4) & 1, fq = 2 * rc + ((el >> 3) & 1), n = (el >> 2) & 1, e = el & 3;
        return 256 * pn + 128 * bj + 32 * wc + 16 * n + 4 * fq + e; }
    case TY_GU: {
        const int bj = c >= DFF ? 1 : 0, j = c - bj * DFF, pn = j >> 7, jj = j & 127, wc = jj >> 5, fq = (jj >> 3) & 3, n = (jj >> 2) & 1, e = jj & 3;
        return 256 * pn + 128 * bj + 32 * wc + 16 * n + 4 * fq + e; }
    default: return pos_s8(c);
    }
}

#define EPI_ARGS const f32x4 (&acc)[2][2][4][2], int pm, int pn, int wr, int wc, int fr, int fq, const LAS float* rs
#define RS_ROW (rs[ai * 128 + wr * 64 + m * 16 + fr])
struct EpiRes {
    static constexpr bool NEEDS_RS = false; RsSrc rsrc;
    float* out; bf16_t* xb; float* ss; int final_;
    __device__ __forceinline__ void operator()(EPI_ARGS) const {
        const int g = 4 * pn + wc;
#pragma unroll
        for (int ai = 0; ai < 2; ++ai)
#pragma unroll
            for (int m = 0; m < 4; ++m) {
                asm volatile("" ::: "memory"); const int row = pm * 256 + ai * 128 + wr * 64 + m * 16 + fr; float s = 0.f;
#pragma unroll
                for (int bj = 0; bj < 2; ++bj) {
                    const size_t off = (size_t)row * DM + 64 * g + 32 * bj + 8 * fq, xoff = tm_off(row, 64 * g + 32 * bj + 8 * fq, DM);
                    const u32x4 b = *(const u32x4*)(xb + xoff);
                    const f32x4 b0 = {__uint_as_float(b.x << 16), __uint_as_float(b.x & 0xffff0000u), __uint_as_float(b.y << 16), __uint_as_float(b.y & 0xffff0000u)};
                    const f32x4 b1 = {__uint_as_float(b.z << 16), __uint_as_float(b.z & 0xffff0000u), __uint_as_float(b.w << 16), __uint_as_float(b.w & 0xffff0000u)};
                    const f32x4 v0 = acc[ai][bj][m][0] + b0, v1 = acc[ai][bj][m][1] + b1;
                    if (final_) { *(f32x4*)(out + off) = v0; *(f32x4*)(out + off + 4) = v1; }
                    else { *(u32x4*)(xb + xoff) = pack8(v0, v1); s += dot4(v0) + dot4(v1); }
                }
                if (!final_) { s = red_fq(s); if (fq == 0) ss[(size_t)row * 16 + g] = s; }
            }
    }
};
struct EpiLatIn {
    static constexpr bool NEEDS_RS = true; RsSrc rsrc;
    bf16_t* lat; float* ssl; bf16_t* kr; const float* knorm  ; const float* tabm;
    __device__ __forceinline__ void operator()(EPI_ARGS) const {
        const int g = 4 * pn + wc;
        if (g == 11) return;
#pragma unroll
        for (int ai = 0; ai < 2; ++ai)
#pragma unroll
            for (int m = 0; m < 4; ++m) {
                asm volatile("" ::: "memory"); const int row = pm * 256 + ai * 128 + wr * 64 + m * 16 + fr;
                const float rstd = RS_ROW;
                if (g < 10) {
                    float s = 0.f;
#pragma unroll
                    for (int bj = 0; bj < 2; ++bj) {
                        const f32x4 v0 = acc[ai][bj][m][0] * rstd, v1 = acc[ai][bj][m][1] * rstd;
                        *(u32x4*)(lat + tm_off(row, 64 * g + 32 * bj + 8 * fq, 768)) = pack8(v0, v1); s += dot4(v0) + dot4(v1);
                    }
                    s = red_fq(s); if (fq == 0) { float* sp = ssl + (size_t)row * 16; sp[g < 6 ? g : g + 2] = s; float z = 0.f; asm volatile("" : "+v"(z)); if (g == 5) { sp[6] = z; sp[7] = z; } if (g == 9) *(f32x4*)(sp + 12) = (f32x4){z, z, z, z}; }
                } else {
                    const bool act = fq < 2; float s = 0.f; f32x4 v[2][2];
#pragma unroll
                    for (int bj = 0; bj < 2; ++bj)
#pragma unroll
                        for (int n = 0; n < 2; ++n) { v[bj][n] = acc[ai][bj][m][n] * rstd; s += act ? dot4(v[bj][n]) : 0.f; }
                    s = red_fq(s);
                    const float r = rsq(s * (1.f / 32.f) + EPS);
                    if (act) {
                        const int t = row & (SEQ - 1), pos = fq == 0 ? (t >> 6) : (t & 63);
#pragma unroll
                        for (int n = 0; n < 2; ++n) {
                            const f32x4 g1 = *(const f32x4*)(knorm + 16 * fq + 4 * n), g2 = *(const f32x4*)(knorm + 16 * fq + 8 + 4 * n);
                            const f32x4 x1 = v[0][n] * r * g1, x2 = v[1][n] * r * g2;
                            const f32x4 cs0 = *(const f32x4*)(tabm + (pos * 8 + 4 * n) * 2), cs1 = *(const f32x4*)(tabm + (pos * 8 + 4 * n) * 2 + 4);
                            const f32x4 c = {cs0[0], cs0[2], cs1[0], cs1[2]}, sn = {cs0[1], cs0[3], cs1[1], cs1[3]};
                            const f32x4 o1 = x1 * c - x2 * sn, o2 = x2 * c + x1 * sn;
                            *(u32x2*)(kr + (size_t)row * 32 + 16 * fq + 4 * n) = pack4(o1);
                            *(u32x2*)(kr + (size_t)row * 32 + 16 * fq + 8 + 4 * n) = pack4(o2);
                        }
                    }
                }
            }
    }
};
struct EpiQ {
    static constexpr bool NEEDS_RS = true; RsSrc rsrc;
    bf16_t* q; const float* qnorm; const float* tabm;
    __device__ __forceinline__ void operator()(EPI_ARGS) const {
        f32x4 gA[2][2];
        if (pn < 4) {
#pragma unroll
            for (int bj = 0; bj < 2; ++bj) { gA[bj][0] = *(const f32x4*)(qnorm + 32 * bj + 8 * fq) * CQ_MLA; gA[bj][1] = *(const f32x4*)(qnorm + 32 * bj + 8 * fq + 4) * CQ_MLA; }
        } else { const int col = 16 * (fq >> 1) + 4 * (fq & 1); gA[0][0] = *(const f32x4*)(qnorm + 64 + col) * CQ_MLA; gA[0][1] = *(const f32x4*)(qnorm + 64 + col + 8) * CQ_MLA; gA[1][0] = gA[0][0]; gA[1][1] = gA[0][1]; }
#pragma unroll
        for (int ai = 0; ai < 2; ++ai)
#pragma unroll
            for (int m = 0; m < 4; ++m) {
                asm volatile("" ::: "memory"); const int row = pm * 256 + ai * 128 + wr * 64 + m * 16 + fr;
                const float rstd = RS_ROW;
                if (pn < 4) {
                    const int h = 4 * pn + wc; float s = 0.f; f32x4 v[2][2];
#pragma unroll
                    for (int bj = 0; bj < 2; ++bj)
#pragma unroll
                        for (int n = 0; n < 2; ++n) { v[bj][n] = acc[ai][bj][m][n] * rstd; s += dot4(v[bj][n]); }
                    s = red_fq(s); const float r = rsq(s * (1.f / 64.f) + EPS);
#pragma unroll
                    for (int bj = 0; bj < 2; ++bj) {
                        const int el = 32 * bj + 8 * fq;
                        *(u32x4*)(q + (size_t)row * 1536 + 96 * h + el) = pack8(v[bj][0] * r * gA[bj][0], v[bj][1] * r * gA[bj][1]);
                    }
                } else {
                    const int t = row & (SEQ - 1), rc = fq >> 1, pos = rc == 0 ? (t >> 6) : (t & 63), i0 = 4 * (fq & 1);
                    const f32x4 cs0 = *(const f32x4*)(tabm + (pos * 8 + i0) * 2), cs1 = *(const f32x4*)(tabm + (pos * 8 + i0) * 2 + 4);
                    const f32x4 c = {cs0[0], cs0[2], cs1[0], cs1[2]}, sn = {cs0[1], cs0[3], cs1[1], cs1[3]};
#pragma unroll
                    for (int bj = 0; bj < 2; ++bj) {
                        const int h = 8 * (pn - 4) + 2 * wc + bj;
                        const f32x4 v1 = acc[ai][bj][m][0] * rstd, v2 = acc[ai][bj][m][1] * rstd;
                        float s = red_fq(dot4(v1) + dot4(v2)); const float r = rsq(s * (1.f / 32.f) + EPS);
                        const int col = 16 * rc + i0;
                        const f32x4 x1 = v1 * r * gA[0][0], x2 = v2 * r * gA[0][1];
                        const f32x4 o1 = x1 * c - x2 * sn, o2 = x2 * c + x1 * sn;
                        bf16_t* dst = q + (size_t)row * 1536 + 96 * h + 64 + col;
                        *(u32x2*)dst = pack4(o1); *(u32x2*)(dst + 8) = pack4(o2);
                    }
                }
            }
    }
};
struct EpiKV {
    static constexpr bool NEEDS_RS = true; RsSrc rsrc;
    bf16_t* kv; const float* knorm;
    __device__ __forceinline__ void operator()(EPI_ARGS) const {
        const int g = 4 * pn + wc; const bool isk = (wc & 1) == 0;
        f32x4 gK[2][2];
#pragma unroll
        for (int bj = 0; bj < 2; ++bj) { gK[bj][0] = (f32x4){1.f, 1.f, 1.f, 1.f}; gK[bj][1] = gK[bj][0];
            if (isk) { gK[bj][0] = *(const f32x4*)(knorm + 32 * bj + 8 * fq); gK[bj][1] = *(const f32x4*)(knorm + 32 * bj + 8 * fq + 4); } }
#pragma unroll
        for (int ai = 0; ai < 2; ++ai)
#pragma unroll
            for (int m = 0; m < 4; ++m) {
                asm volatile("" ::: "memory"); const int row = pm * 256 + ai * 128 + wr * 64 + m * 16 + fr;
                const float rstd = RS_ROW;
                f32x4 v[2][2]; float s = 0.f;
#pragma unroll
                for (int bj = 0; bj < 2; ++bj)
#pragma unroll
                    for (int n = 0; n < 2; ++n) { v[bj][n] = acc[ai][bj][m][n] * rstd; s += dot4(v[bj][n]); }
                float r = 1.f;
                if (isk) { s = red_fq(s); r = rsq(s * (1.f / 64.f) + EPS); }
#pragma unroll
                for (int bj = 0; bj < 2; ++bj) {
                    const int el = 32 * bj + 8 * fq;
                    *(u32x4*)(kv + (size_t)row * 2048 + 64 * g + el) = pack8(v[bj][0] * r * gK[bj][0], v[bj][1] * r * gK[bj][1]);
                }
            }
    }
};
struct EpiQKV {
    static constexpr bool NEEDS_RS = true; RsSrc rsrc;
    bf16_t* qkv; const float* qnorm; const float* knorm; const float* tabg;
    __device__ __forceinline__ void operator()(EPI_ARGS) const {
        const int g = 4 * pn + wc;
        f32x4 gQ[2][2];
        if (g < 20) { const float* gn = g < 16 ? qnorm : knorm; const float sc = g < 16 ? CQ_GQA : 1.f;
#pragma unroll
            for (int n = 0; n < 2; ++n) { gQ[n][0] = *(const f32x4*)(gn + 32 * (fq >> 1) + 8 * (fq & 1) + 4 * n) * sc; gQ[n][1] = *(const f32x4*)(gn + 32 * (fq >> 1) + 8 * (fq & 1) + 4 * n + 16) * sc; } }
#pragma unroll
        for (int ai = 0; ai < 2; ++ai)
#pragma unroll
            for (int m = 0; m < 4; ++m) {
                asm volatile("" ::: "memory"); const int row = pm * 256 + ai * 128 + wr * 64 + m * 16 + fr;
                const float rstd = RS_ROW;
                if (g >= 20) {
#pragma unroll
                    for (int bj = 0; bj < 2; ++bj)
                        *(u32x4*)(qkv + (size_t)row * 1536 + 64 * g + 32 * bj + 8 * fq) = pack8(acc[ai][bj][m][0] * rstd, acc[ai][bj][m][1] * rstd);
                } else {
                    f32x4 v[2][2]; float s = 0.f;
#pragma unroll
                    for (int bj = 0; bj < 2; ++bj)
#pragma unroll
                        for (int n = 0; n < 2; ++n) { v[bj][n] = acc[ai][bj][m][n] * rstd; s += dot4(v[bj][n]); }
                    s = red_fq(s); const float r = rsq(s * (1.f / 64.f) + EPS);
                    const int t = row & (SEQ - 1), pos = (fq >> 1) == 0 ? (t >> 6) : (t & 63);
                    f32x4 o1[2], o2[2];
#pragma unroll
                    for (int n = 0; n < 2; ++n) {
                        const float* tp = tabg + (pos * 16 + 8 * (fq & 1) + 4 * n) * 2;
                        const f32x4 cs0 = *(const f32x4*)tp, cs1 = *(const f32x4*)(tp + 4);
                        const f32x4 c = {cs0[0], cs0[2], cs1[0], cs1[2]}, sn = {cs0[1], cs0[3], cs1[1], cs1[3]};
                        const f32x4 x1 = v[0][n] * r * gQ[n][0], x2 = v[1][n] * r * gQ[n][1];
                        o1[n] = x1 * c - x2 * sn; o2[n] = x2 * c + x1 * sn;
                    }
                    bf16_t* dst = qkv + (size_t)row * 1536 + 64 * g + 32 * (fq >> 1) + 8 * (fq & 1);
                    *(u32x4*)dst = pack8(o1[0], o1[1]); *(u32x4*)(dst + 16) = pack8(o2[0], o2[1]);
                }
            }
    }
};
struct EpiGU {
    static constexpr bool NEEDS_RS = true; RsSrc rsrc;
    bf16_t* h;
    __device__ __forceinline__ void operator()(EPI_ARGS) const {
#pragma unroll
        for (int ai = 0; ai < 2; ++ai)
#pragma unroll
            for (int m = 0; m < 4; ++m) {
                asm volatile("" ::: "memory"); const int row = pm * 256 + ai * 128 + wr * 64 + m * 16 + fr;
                const float rstd = RS_ROW;
                f32x4 o[2];
#pragma unroll
                for (int n = 0; n < 2; ++n) {
                    const f32x4 gg = acc[ai][0][m][n] * rstd, uu = acc[ai][1][m][n] * rstd;
#pragma unroll
                    for (int e = 0; e < 4; ++e) o[n][e] = gg[e] * __builtin_amdgcn_rcpf(1.f + __builtin_amdgcn_exp2f(-1.4426950408889634f * gg[e])) * uu[e];
                }
                *(u32x4*)(h + tm_off(row, 128 * pn + 32 * wc + 8 * fq, DFF)) = pack8(o[0], o[1]);
            }
    }
};

namespace att {
constexpr int QBLK = 32, KVBLK = 64, NT = SEQ / KVBLK;
#define SBAR() __builtin_amdgcn_sched_barrier(0)
__device__ __forceinline__ int crow(int r, int hi) { return (r & 3) + 8 * (r >> 2) + 4 * hi; }
__device__ __forceinline__ int v_st(int k, int c) { const int kk = (k & ~0xC) | ((k & 4) << 1) | ((k & 8) >> 1); return ((kk >> 3) * 2 + (c >> 5)) * 512 + ((kk & 7) * 32 + (c & 31)) * 2; }
__device__ __forceinline__ int v_rd_base(int lane) { return ((lane & 3) << 3) | (((lane >> 2) & 3) << 6) | (((lane >> 4) & 1) << 5) | (((lane >> 5) & 1) << 10); }
constexpr int v_rd_off(int d0, int ks, int half) { return d0 * 512 + ks * 2048 + half * 256; }
template <int OFF> __device__ __forceinline__ s16x4 tr_read(int vb) { s16x4 r; asm volatile("ds_read_b64_tr_b16 %0, %1 offset:%2" : "=&v"(r) : "v"(vb), "i"(OFF) : "memory"); return r; }
#define PKV(L, H) (bf16x8){L[0], L[1], L[2], L[3], H[0], H[1], H[2], H[3]}
template <int KS0, bool SUMV> __device__ __forceinline__ void pv_half(f32x16* o, f32x16& ol, int vb, bf16x8 paA, bf16x8 paB) {
    const bf16x8 ones = {0x3F80, 0x3F80, 0x3F80, 0x3F80, 0x3F80, 0x3F80, 0x3F80, 0x3F80};
    const s16x4 l00 = tr_read<v_rd_off(0, KS0, 0)>(vb), h00 = tr_read<v_rd_off(0, KS0, 1)>(vb), l10 = tr_read<v_rd_off(1, KS0, 0)>(vb), h10 = tr_read<v_rd_off(1, KS0, 1)>(vb);
    const s16x4 l01 = tr_read<v_rd_off(0, KS0 + 1, 0)>(vb), h01 = tr_read<v_rd_off(0, KS0 + 1, 1)>(vb), l11 = tr_read<v_rd_off(1, KS0 + 1, 0)>(vb), h11 = tr_read<v_rd_off(1, KS0 + 1, 1)>(vb);
    asm volatile("s_waitcnt lgkmcnt(0)" ::: "memory"); SBAR();
    o[0] = __builtin_amdgcn_mfma_f32_32x32x16_bf16(paA, PKV(l00, h00), o[0], 0, 0, 0);
    o[1] = __builtin_amdgcn_mfma_f32_32x32x16_bf16(paA, PKV(l10, h10), o[1], 0, 0, 0);
    if constexpr (!SUMV) ol = __builtin_amdgcn_mfma_f32_32x32x16_bf16(paA, ones, ol, 0, 0, 0);
    o[0] = __builtin_amdgcn_mfma_f32_32x32x16_bf16(paB, PKV(l01, h01), o[0], 0, 0, 0);
    o[1] = __builtin_amdgcn_mfma_f32_32x32x16_bf16(paB, PKV(l11, h11), o[1], 0, 0, 0);
    if constexpr (!SUMV) ol = __builtin_amdgcn_mfma_f32_32x32x16_bf16(paB, ones, ol, 0, 0, 0);
}
template <bool SUMV> __device__ __forceinline__ void pv_all(f32x16* o, f32x16& ol, int vb, bf16x8 pa0, bf16x8 pa1, bf16x8 pa2, bf16x8 pa3) { pv_half<0, SUMV>(o, ol, vb, pa0, pa1); pv_half<2, SUMV>(o, ol, vb, pa2, pa3); }
__device__ __forceinline__ float rowmax32(const f32x16& p0, const f32x16& p1) {
    float a = fmaxf(fmaxf(p0[0], p0[1]), p1[0]), b = fmaxf(fmaxf(p0[2], p0[3]), p1[1]); a = fmaxf(fmaxf(a, p1[2]), p1[3]);
#pragma unroll
    for (int r = 4; r < 16; r += 4) { a = fmaxf(fmaxf(a, p0[r]), p0[r + 1]); b = fmaxf(fmaxf(b, p0[r + 2]), p0[r + 3]); a = fmaxf(fmaxf(a, p1[r]), p1[r + 1]); b = fmaxf(fmaxf(b, p1[r + 2]), p1[r + 3]); }
    float m = fmaxf(a, b);
    auto rr = __builtin_amdgcn_permlane32_swap(__float_as_uint(m), __float_as_uint(m), false, false); return fmaxf(__uint_as_float(rr[0]), __uint_as_float(rr[1]));
}
template <bool FIRST, bool NOMAX>
__device__ __forceinline__ void partialSM(f32x16& p0, f32x16& p1, float& m_reg, f32x16& negm, float& alpha) {
    if constexpr (NOMAX) { alpha = 1.f;
#pragma unroll
        for (int r = 0; r < 16; ++r) p0[r] = __builtin_amdgcn_exp2f(p0[r]);
        return; }
    constexpr float THRL = 11.5f;
    const float rm = rowmax32(p0, p1);
    alpha = 1.f;
    if (FIRST || !__builtin_expect(__all(rm <= THRL), 1)) {
        const float dl = FIRST ? rm : fmaxf(rm, 0.f); m_reg += dl;
        if (!FIRST) alpha = __builtin_amdgcn_exp2f(-dl);
        p0 = p0 - dl; p1 = p1 - dl;
#pragma unroll
        for (int r = 0; r < 16; ++r) negm[r] = -m_reg;
    }
    asm volatile("" : "+v"(negm));
#pragma unroll
    for (int r = 0; r < 16; ++r) p0[r] = __builtin_amdgcn_exp2f(p0[r]);
}
template <bool SUMV>
__device__ __forceinline__ void finishSM(f32x16& p0, f32x16& p1, float& l_reg, bf16x8& pa0, bf16x8& pa1, bf16x8& pa2, bf16x8& pa3) {
#pragma unroll
    for (int r = 0; r < 16; ++r) p1[r] = __builtin_amdgcn_exp2f(p1[r]);
    if constexpr (SUMV) {
        float sa = l_reg, sb = 0.f;
#pragma unroll
        for (int r = 0; r < 16; ++r) { sa += p0[r]; sb += p1[r]; }
        l_reg = sa + sb;
    }
#define PK4(P, BASE, OUT) do { const u32x4 w = {cvtpk(P[BASE + 0], P[BASE + 1]), cvtpk(P[BASE + 2], P[BASE + 3]), cvtpk(P[BASE + 4], P[BASE + 5]), cvtpk(P[BASE + 6], P[BASE + 7])}; OUT = __builtin_bit_cast(bf16x8, w); } while (0)
    PK4(p0, 0, pa0); PK4(p0, 8, pa1); PK4(p1, 0, pa2); PK4(p1, 8, pa3);
#undef PK4
}
template <int DK> struct Geo {
    static constexpr int SHM_V = KVBLK * 64 * 2, SHM_K = (DK / 8) * 1024;
    static constexpr int OFF_V = 0, OFF_K = 4 * SHM_V, OFF_WS = OFF_K + 4 * SHM_K, OFF_OST = OFF_WS + NWAVES * 256, BYTES = OFF_OST + NWAVES * 4096;
};
template <int DK, bool NOMAX>
__device__ __forceinline__ void qkt(f32x16& p0, f32x16& p1, const char* Ks, const bf16x8* qr, const f32x16& negm, int r32, int hi) {
#pragma unroll
    for (int d0 = 0; d0 < DK / 16; ++d0) {
        const char* kb = d0 < 4 ? Ks + r32 * 128 + (((2 * d0 + hi) ^ ((r32 >> 1) & 7)) << 4) : Ks + 8192 + r32 * 64 + (((2 * (d0 - 4) + hi) ^ ((r32 >> 2) & 3)) << 4);
        const bf16x8 b0 = *reinterpret_cast<const bf16x8*>(kb);
        const bf16x8 b1 = *reinterpret_cast<const bf16x8*>(kb + (d0 < 4 ? 4096 : 2048));
        if (d0 == 0) { if constexpr (NOMAX) { p0 = __builtin_amdgcn_mfma_f32_32x32x16_bf16(b0, qr[0], f32x16{}, 0, 0, 0); p1 = __builtin_amdgcn_mfma_f32_32x32x16_bf16(b1, qr[0], f32x16{}, 0, 0, 0); }
                       else { p0 = __builtin_amdgcn_mfma_f32_32x32x16_bf16(b0, qr[0], negm, 0, 0, 0); p1 = __builtin_amdgcn_mfma_f32_32x32x16_bf16(b1, qr[0], negm, 0, 0, 0); } }
        else { p0 = __builtin_amdgcn_mfma_f32_32x32x16_bf16(b0, qr[d0], p0, 0, 0, 0); p1 = __builtin_amdgcn_mfma_f32_32x32x16_bf16(b1, qr[d0], p1, 0, 0, 0); } }
}
template <int DK, bool NOMAX>
__device__ __forceinline__ void attn_phase(const bf16_t* __restrict__ Qbuf, const bf16_t* __restrict__ KVbuf, const bf16_t* __restrict__ KRbuf, bf16_t* __restrict__ AObuf, const int vcu, const int G_, char* lds) {
    using G = Geo<DK>; constexpr int SHM_V = G::SHM_V, SHM_K = G::SHM_K, ND = DK / 16, NU = NB * 16 * 8;
    constexpr int ldq = 1536, ldk = (DK == 96) ? 2048 : 1536, ldv = ldk, ldo = 1024;
    int tid = threadIdx.x; asm volatile("" : "+v"(tid));
    const int wid = __builtin_amdgcn_readfirstlane(tid >> 6), lane = tid & 63, r32 = lane & 31, hi = lane >> 5;
    char* V_lds = lds + G::OFF_V; char* K_lds = lds + G::OFF_K;
    float* al_l = (float*)(lds + G::OFF_WS) + wid * 64;
    const bool xk = (DK == 96) && (wid < 4);
    const int vb0 = (int)(uintptr_t)V_lds + v_rd_base(lane);
    LAS unsigned char* ldsl = (LAS unsigned char*)lds;
    const int vkk = 8 * wid + ((lane & 31) >> 2), vk = (vkk & ~0xC) | ((vkk & 4) << 1) | ((vkk & 8) >> 1);
    const int kr_ = 8 * wid + (lane >> 3), kr2_ = 16 * wid + (lane >> 2);
    const unsigned koff = (unsigned)(kr_ * ldk + (((lane & 7) ^ ((kr_ >> 1) & 7)) << 3)) * 2u, k2off = (unsigned)(kr2_ * 32 + (((lane & 3) ^ ((kr2_ >> 2) & 3)) << 3)) * 2u, voff = (unsigned)(vk * ldv + 32 * (lane >> 5) + 8 * (lane & 3)) * 2u;
#define UDEC(u_, Qp, Kp, K2p, Vp, Op) do { const int bh_ = (u_) >> 3, qb_ = (u_) & 7, b_ = bh_ >> 4, h_ = bh_ & 15; const size_t r0_ = (size_t)b_ * SEQ; \
        if (DK == 96) { Qp = Qbuf + (r0_ + qb_ * 256) * 1536 + h_ * 96; Kp = KVbuf + r0_ * 2048 + h_ * 128; K2p = KRbuf + r0_ * 32; Vp = KVbuf + r0_ * 2048 + h_ * 128 + 64; } \
        else { Qp = Qbuf + (r0_ + qb_ * 256) * 1536 + h_ * 64; Kp = Qbuf + r0_ * 1536 + 1024 + (h_ >> 2) * 64; K2p = Kp; Vp = Qbuf + r0_ * 1536 + 1280 + (h_ >> 2) * 64; } \
        Op = AObuf + (r0_ + qb_ * 256) * 1024 + h_ * 64; } while (0)
#define GLDS(src, off) __builtin_amdgcn_global_load_lds((const unsigned*)(src), (LAS unsigned*)(ldsl + (off)), 16, 0, 0)
#define DMA_K(kp, k2p, t, sl) do { GLDS((const char*)((kp) + (size_t)(t) * KVBLK * ldk) + koff, G::OFF_K + (sl) * SHM_K + wid * 1024); if (xk) GLDS((const char*)((k2p) + (size_t)(t) * KVBLK * 32) + k2off, G::OFF_K + (sl) * SHM_K + (8 + wid) * 1024); } while (0)
#define DMA_V(vp, t, sl) GLDS((const char*)((vp) + (size_t)(t) * KVBLK * ldv) + voff, G::OFF_V + (sl) * SHM_V + wid * 1024)
#define WAITBAR(N) asm volatile("s_waitcnt vmcnt(" #N ") lgkmcnt(0)\n\ts_barrier" ::: "memory")
#define WAITBAR_C() do { if (xk) WAITBAR(3); else WAITBAR(2); } while (0)
#define RESC(a) do { if (__any((a) < 1.f)) { if (hi == 0) al_l[r32] = (a); asm volatile("s_waitcnt lgkmcnt(0)" ::: "memory"); \
    _Pragma("unroll") for (int r = 0; r < 16; ++r) { const float f_ = al_l[crow(r, hi)]; o[0][r] *= f_; o[1][r] *= f_; ol[r] *= f_; } } } while (0)
#define ROT3() do { const int t_ = sA; sA = sB; sB = sC; sC = t_; } while (0)
    int u = vcu; if (u >= NU) return;
    const bf16_t *Qc, *kC, *k2C, *vC; bf16_t* Oc; UDEC(u, Qc, kC, k2C, vC, Oc);
    bf16x8 qr[ND];
    { const bf16_t* Qw = Qc + (size_t)(wid * QBLK + r32) * ldq + hi * 8;
#pragma unroll
      for (int d0 = 0; d0 < ND; ++d0) qr[d0] = *reinterpret_cast<const bf16x8*>(Qw + d0 * 16); }
    DMA_K(kC, k2C, 0, 0); DMA_V(vC, 0, 0); DMA_K(kC, k2C, 1, 1);
    WAITBAR(0);
    for (;;) {
        const int un = u + G_; const bool has_next = un < NU;
        float m_reg = 0.f, l_reg = 0.f; f32x16 o[2] = {}; f32x16 ol = {}; f32x16 negm = {}; asm volatile("" : "+v"(negm));
        f32x16 pA0, pA1, pB0, pB1; float alA, alB; bf16x8 pa0, pa1, pa2, pa3;
#define SDMA(j) do {   \
        if ((j) + 2 < NT) { DMA_K(kC, k2C, (j) + 2, ((j) + 2) & 3); DMA_K(kC, k2C, (j) + 3, ((j) + 3) & 3); DMA_V(vC, (j) + 1, ((j) + 1) & 3); DMA_V(vC, (j) + 2, ((j) + 2) & 3); } \
        else { DMA_V(vC, (j) + 1, ((j) + 1) & 3); if (has_next) { const bf16_t *Qn, *kN, *k2N, *vN; bf16_t* On; UDEC(un, Qn, kN, k2N, vN, On); (void)Qn; (void)On; DMA_K(kN, k2N, 0, 0); DMA_K(kN, k2N, 1, 1); DMA_V(vN, 0, 0); } } } while (0)
#define STEP(PC0, PC1, PP0, PP1, alC, j) do { SBAR(); \
        qkt<DK, NOMAX>(PC0, PC1, K_lds + ((j) & 3) * SHM_K, qr, negm, r32, hi); \
        finishSM<NOMAX>(PP0, PP1, l_reg, pa0, pa1, pa2, pa3); SBAR(); \
        pv_all<NOMAX>(o, ol, vb0 + (((j) - 1) & 3) * SHM_V, pa0, pa1, pa2, pa3); partialSM<false, NOMAX>(PC0, PC1, m_reg, negm, alC); \
        if constexpr (!NOMAX) RESC(alC); SBAR(); } while (0)
        SDMA(0);
        qkt<DK, NOMAX>(pA0, pA1, K_lds, qr, negm, r32, hi); partialSM<true, NOMAX>(pA0, pA1, m_reg, negm, alA);
        STEP(pB0, pB1, pA0, pA1, alB, 1); WAITBAR(0);
        for (int j = 2; j < NT; j += 2) {
            SBAR(); SDMA(j); SBAR();
            STEP(pA0, pA1, pB0, pB1, alA, j);
            STEP(pB0, pB1, pA0, pA1, alB, j + 1); WAITBAR(0);
        }
#undef STEP
#undef SDMA
        finishSM<NOMAX>(pB0, pB1, l_reg, pa0, pa1, pa2, pa3); SBAR();
        if (has_next) { const bf16_t *Qn, *kN, *k2N, *vN; bf16_t* On; UDEC(un, Qn, kN, k2N, vN, On); (void)kN; (void)k2N; (void)vN; (void)On; const bf16_t* Qw = Qn + (size_t)(wid * QBLK + r32) * ldq + hi * 8;
#pragma unroll
            for (int d0 = 0; d0 < ND; ++d0) qr[d0] = *reinterpret_cast<const bf16x8*>(Qw + d0 * 16); }
        pv_all<NOMAX>(o, ol, vb0 + ((NT - 1) & 3) * SHM_V, pa0, pa1, pa2, pa3);
        const int orow0 = ((u >> 7) * SEQ) + (u & 7) * 256 + wid * QBLK, ocol0 = ((u >> 3) & 15) * 64; (void)Oc;
        { bf16_t* stg = (bf16_t*)(lds + G::OFF_OST) + wid * 2048;
          if constexpr (NOMAX) { auto rr = __builtin_amdgcn_permlane32_swap(__float_as_uint(l_reg), __float_as_uint(l_reg), false, false); l_reg = __uint_as_float(rr[0]) + __uint_as_float(rr[1]);
              if (hi == 0) al_l[r32] = l_reg; asm volatile("s_waitcnt lgkmcnt(0)" ::: "memory");
#pragma unroll
              for (int r = 0; r < 16; ++r) ol[r] = al_l[crow(r, hi)]; }
#pragma unroll
          for (int r = 0; r < 16; ++r) { const int orow = crow(r, hi); const float rl = __builtin_amdgcn_rcpf(ol[r]);
#pragma unroll
            for (int d0 = 0; d0 < 2; ++d0) stg[orow * 64 + d0 * 32 + r32] = (bf16_t)(cvtpk(o[d0][r] * rl, 0.f) & 0xffffu); }
          asm volatile("s_waitcnt lgkmcnt(0)" ::: "memory");
#pragma unroll
          for (int i = 0; i < 4; ++i) { const int row = i * 8 + (lane >> 3), ch = lane & 7; const u32x4 v = *(const u32x4*)(stg + row * 64 + ch * 8); *(u32x4*)(AObuf + tm_off(orow0 + row, ocol0 + ch * 8, ldo)) = v; } }
        if (!has_next) break;
        u = un; UDEC(u, Qc, kC, k2C, vC, Oc);
    }
    asm volatile("s_waitcnt vmcnt(0) lgkmcnt(0)" ::: "memory"); __syncthreads();
#undef UDEC
#undef GLDS
#undef DMA_K
#undef DMA_V
#undef WAITBAR
#undef WAITBAR_C
#undef RESC
#undef ROT3
}
}

__device__ __forceinline__ void transpose_item(const float* W, int K, int N, const float* gain, bf16_t* WT, int type, LAS float* scr, int item, int lane) {
    const int nblk = N / 32, kb = item / nblk, nb = item % nblk, k0 = 64 * kb, n0 = 32 * nb;
    const int kr = lane >> 3, nc = (lane & 7) * 4;
    f32x4 v[8];
#pragma unroll
    for (int i = 0; i < 8; ++i) v[i] = *(const f32x4*)(W + (size_t)(k0 + 8 * i + kr) * N + n0 + nc);
#pragma unroll
    for (int i = 0; i < 8; ++i) { const int kk = 8 * i + kr; const float gv = gain ? gain[k0 + kk] : 1.f; LAS float* d = scr + kk * 33 + nc;
        d[0] = v[i][0] * gv; d[1] = v[i][1] * gv; d[2] = v[i][2] * gv; d[3] = v[i][3] * gv; }
    asm volatile("s_waitcnt lgkmcnt(0)" ::: "memory");
    const int c = lane & 7;
#pragma unroll
    for (int j = 0; j < 4; ++j) { const int n = (lane >> 3) + 8 * j; const LAS float* s = scr + (8 * c) * 33 + n;
        u32x4 o; o.x = cvtpk(s[0 * 33], s[1 * 33]); o.y = cvtpk(s[2 * 33], s[3 * 33]); o.z = cvtpk(s[4 * 33], s[5 * 33]); o.w = cvtpk(s[6 * 33], s[7 * 33]);
        { const int pos_ = dstrow(type, n0 + n); *(u32x4*)((char*)WT + ((size_t)(pos_ >> 7) * (K / 64) + (k0 >> 6)) * pg8::HTB + pg8::lds_byte(pos_ & 127, 8 * c)) = o; } }
    asm volatile("s_waitcnt lgkmcnt(0)" ::: "memory");
}
struct MatInfo { const float* W; const float* gain; bf16_t* WT; int K, N, type; };

struct Args { const float* in[18]; float* out; unsigned char* ws; int ph_lo, ph_hi; };

__device__ __forceinline__ MatInfo mat_info(const Args& a, int mi) {
    MatInfo r; bf16_t* wb = (bf16_t*)(a.ws + WS_W);
    if (mi < 8) { const int j = mi >> 2, w = mi & 3; bf16_t* base = wb + WOFF_MLA + (size_t)j * W_MLA_E;
        if (w == 0) { r.W = a.in[2] + (size_t)j * 1024 * 672; r.gain = a.in[1] + j * 1024; r.WT = base; r.K = 1024; r.N = 672; r.type = TY_WIN; }
        else if (w == 1) { r.W = a.in[4] + (size_t)j * 384 * 1536; r.gain = a.in[3] + j * 384; r.WT = base + W_IN_E; r.K = 384; r.N = 1536; r.type = TY_WUQ; }
        else if (w == 2) { r.W = a.in[6] + (size_t)j * 256 * 2048; r.gain = a.in[5] + j * 256; r.WT = base + W_IN_E + W_UQ_E; r.K = 256; r.N = 2048; r.type = TY_S8; }
        else { r.W = a.in[9] + (size_t)j * 1024 * 1024; r.gain = nullptr; r.WT = base + W_IN_E + W_UQ_E + W_UKV_E; r.K = 1024; r.N = 1024; r.type = TY_S8; }
    } else if (mi < 12) { const int j = (mi - 8) >> 1, w = (mi - 8) & 1; bf16_t* base = wb + WOFF_GQA + (size_t)j * W_GQA_E;
        if (w == 0) { r.W = a.in[11] + (size_t)j * 1024 * 1536; r.gain = a.in[10] + j * 1024; r.WT = base; r.K = 1024; r.N = 1536; r.type = TY_GQKV; }
        else { r.W = a.in[14] + (size_t)j * 1024 * 1024; r.gain = nullptr; r.WT = base + W_QKV_E; r.K = 1024; r.N = 1024; r.type = TY_S8; }
    } else { const int i = (mi - 12) >> 1, w = (mi - 12) & 1; bf16_t* base = wb + WOFF_FFN + (size_t)i * W_FFN_E;
        if (w == 0) { r.W = a.in[16] + (size_t)i * 1024 * 5632; r.gain = a.in[15] + i * 1024; r.WT = base; r.K = 1024; r.N = 5632; r.type = TY_GU; }
        else { r.W = a.in[17] + (size_t)i * 2816 * 1024; r.gain = nullptr; r.WT = base + W_GU_E; r.K = 2816; r.N = 1024; r.type = TY_S8; }
    }
    return r;
}


constexpr size_t WS_BAR = 16384, BAR_BYTES = 16384;
#define XB_TMO      128
#define XB_XCNT(j)  (256  + 64 * (j))
#define XB_XSUB(j)  (1280 + 64 * (j))
#define XB_XGEN(j)  (2304 + 64 * (j))
#define XB_TOP      3328
#define XB_TOPGEN   3392
#define XB_SPIN_CAP (1u << 22)
__device__ __forceinline__ unsigned xb_ld(unsigned* p)              { return __hip_atomic_load(p, __ATOMIC_RELAXED, __HIP_MEMORY_SCOPE_AGENT); }
__device__ __forceinline__ unsigned xb_add(unsigned* p, unsigned v) { return __hip_atomic_fetch_add(p, v, __ATOMIC_RELAXED, __HIP_MEMORY_SCOPE_AGENT); }
__device__ __forceinline__ unsigned xb_xcc_id() { return (unsigned)__builtin_amdgcn_s_getreg((3 << 11) | 20) & 0xFu; }
#define XB_SPIN(cond, bar) do { unsigned _sp = 0; while (cond) { __builtin_amdgcn_s_sleep(1); \
    if ((++_sp & 255u) == 0u) { if (xb_ld(&(bar)[XB_TMO])) break; if (_sp > XB_SPIN_CAP) { atomicAdd(&(bar)[XB_TMO], 1u); break; } } } } while (0)
struct XcdBarrier { unsigned* bar; unsigned x; volatile LAS unsigned* st; };
__device__ __forceinline__ XcdBarrier xcd_barrier_post(unsigned* bar, volatile LAS unsigned* st) {
    XcdBarrier b; b.bar = bar; b.x = xb_xcc_id(); b.st = st;
    if (threadIdx.x == 0) (void)xb_add(&bar[XB_XCNT(b.x)], 1u);
    return b;
}
__device__ __forceinline__ void xcd_barrier_complete(unsigned* bar, unsigned x, unsigned& nloc, unsigned& nx) {
    const unsigned G = gridDim.x * gridDim.y * gridDim.z;
    unsigned sum, cnt, mine, sp = 0u;
    for (;;) {
        sum = 0u; cnt = 0u; mine = 0u;
#pragma unroll
        for (unsigned j = 0; j < 16; ++j) { const unsigned c = xb_ld(&bar[XB_XCNT(j)]); sum += c; cnt += (c > 0u) ? 1u : 0u; mine = (j == x) ? c : mine; }
        if (sum == G) break;
        __builtin_amdgcn_s_sleep(1);
        if ((++sp & 255u) == 0u) { if (xb_ld(&bar[XB_TMO])) break; if (sp > XB_SPIN_CAP) { atomicAdd(&bar[XB_TMO], 1u); break; } }
    }
    nloc = mine > 0u ? mine : 1u; nx = cnt > 0u ? cnt : 1u;
}
__device__ __forceinline__ void xcd_barrier(const XcdBarrier& b) {
    asm volatile("s_waitcnt vmcnt(0)" ::: "memory");
    __syncthreads();
    if (threadIdx.x == 0) {
        unsigned* bar = b.bar;
        __builtin_amdgcn_s_waitcnt(0);
        unsigned nloc = b.st[0], nx = b.st[1];
        if (nloc == 0u) { xcd_barrier_complete(bar, b.x, nloc, nx); b.st[0] = nloc; b.st[1] = nx; }
        const unsigned old = xb_add(&bar[XB_XSUB(b.x)], 1u);
        const unsigned gen = old / nloc;
        if (old + 1u == (gen + 1u) * nloc) {
            __builtin_amdgcn_fence(__ATOMIC_RELEASE, "agent");
            asm volatile("s_waitcnt vmcnt(0)" ::: "memory");
            const unsigned og = xb_add(&bar[XB_TOP], 1u);
            const unsigned tg = og / nx;
            if (og + 1u == (tg + 1u) * nx) xb_add(&bar[XB_TOPGEN], 1u);
            else XB_SPIN(xb_ld(&bar[XB_TOPGEN]) == tg, bar);
            __builtin_amdgcn_fence(__ATOMIC_ACQUIRE, "agent");
            xb_add(&bar[XB_XGEN(b.x)], 1u);
            asm volatile("s_waitcnt vmcnt(0)" ::: "memory");
        } else {
            XB_SPIN(xb_ld(&bar[XB_XGEN(b.x)]) == gen, bar);
            __builtin_amdgcn_fence(__ATOMIC_ACQUIRE, "agent");
            asm volatile("s_waitcnt vmcnt(0)" ::: "memory");
        }
    }
    __syncthreads();
}
__device__ __forceinline__ float gain_absmax(const float* g, int n, int lane) {
    asm volatile("" : "+v"(lane));
    float v = lane < n ? fabsf(g[lane]) : 0.f;
#pragma unroll
    for (int o = 1; o < 64; o <<= 1) v = fmaxf(v, __shfl_xor(v, o));
    return v;
}
constexpr int LDS_BYTES = 147456;
constexpr int N_PHASES = 1 + 6 + 5 + 6 + 5;
__global__ void __launch_bounds__(512, 2) fwd_mega(Args a) {
    extern __shared__ __attribute__((aligned(16))) unsigned char lds[];
    cg::grid_group grid = cg::this_grid();
    const int tid = threadIdx.x, lane = tid & 63, wave = __builtin_amdgcn_readfirstlane(tid >> 6);
    const int G = gridDim.x, bx = blockIdx.x;
    const int vcu = (G % 8 == 0) ? (bx % 8) * (G / 8) + bx / 8 : bx;
    LAS unsigned char* ldsl = (LAS unsigned char*)lds;
    unsigned char* ws = a.ws;
    float* SS = (float*)(ws + WS_SS); float* SSL = (float*)(ws + WS_SSL);
    bf16_t* KR = (bf16_t*)(ws + WS_KR); bf16_t* XB = (bf16_t*)(ws + WS_XB); bf16_t* AO = (bf16_t*)(ws + WS_AO);
    bf16_t* HB = (bf16_t*)(ws + WS_B); bf16_t* LAT = HB; bf16_t* QB = (bf16_t*)(ws + WS_B + 96 * MiB); bf16_t* QKV = HB;
    bf16_t* KV = (bf16_t*)(ws + WS_KV);
    const float* TABM = (const float*)(ws + WS_TABM); const float* TABG = (const float*)(ws + WS_TABG);
    bf16_t* WB = (bf16_t*)(ws + WS_W);
    const int lo = a.ph_lo, hi = a.ph_hi;
    int ph = 0;
    volatile LAS unsigned* MISC = (volatile LAS unsigned*)(ldsl + 131072);
    if (tid < 4) MISC[tid] = 0u;
    __syncthreads();
    XcdBarrier xbar = xcd_barrier_post((unsigned*)(ws + WS_BAR), MISC);
#define PHASE_BEGIN if (lo <= ph && ph < hi) {
#define PHASE_END   if (ph + 1 < hi) { if (ph == 0) grid.sync(); else xcd_barrier(xbar); } } ++ph;

    PHASE_BEGIN
    {
        LAS float* scr = (LAS float*)(ldsl + wave * 16384);
        const int gw = vcu * NWAVES + wave, NGW = G * NWAVES;
        int base = 0;
        for (int mi = 0; mi < 20; ++mi) {
            const MatInfo mt = mat_info(a, mi); const int items = (mt.K / 64) * (mt.N / 32);
            int first = (gw - base % NGW + NGW) % NGW;
            for (int it = first; it < items; it += NGW) transpose_item(mt.W, mt.K, mt.N, mt.gain, mt.WT, mt.type, scr, it, lane);
            base += items;
        }
        for (int j = 0; j < 2; ++j) { bf16_t* wt = WB + WOFF_MLA + (size_t)j * W_MLA_E;
            for (int idx = gw; idx < 256; idx += NGW) { const int p = idx, wc = (p >> 5) & 3, fq = (p >> 2) & 3;
                if (wc == 3 || (wc == 2 && fq >= 2)) { u32x4 z = {0u, 0u, 0u, 0u}; const int pos_ = 512 + p; for (int k = lane * 8; k < 1024; k += 512) *(u32x4*)((char*)wt + ((size_t)(pos_ >> 7) * 16 + (k >> 6)) * pg8::HTB + pg8::lds_byte(pos_ & 127, k & 63)) = z; } } }
        { const int gt = bx * 512 + tid;
          if (gt < 512) { const int pos = gt >> 3, j = gt & 7; const float inv = exp2f(-(float)j * (13.287712379549449f / 8.f)); const float ang = (float)pos * inv;
              ((float*)(ws + WS_TABM))[gt * 2] = cosf(ang); ((float*)(ws + WS_TABM))[gt * 2 + 1] = sinf(ang); }
          else if (gt < 512 + 1024) { const int i = gt - 512, pos = i >> 4, j = i & 15; const float inv = exp2f(-(float)j * (13.287712379549449f / 16.f)); const float ang = (float)pos * inv;
              ((float*)(ws + WS_TABG))[i * 2] = cosf(ang); ((float*)(ws + WS_TABG))[i * 2 + 1] = sinf(ang); } }
        for (int r = gw * 4; r < T; r += NGW * 4) {
            f32x4 v[4][4];
#pragma unroll
            for (int q = 0; q < 4; ++q)
#pragma unroll
                for (int j = 0; j < 4; ++j) v[q][j] = ((const f32x4*)(a.in[0] + (size_t)(r + q) * DM) + lane)[64 * j];
#pragma unroll
            for (int q = 0; q < 4; ++q) { float s = 0.f;
#pragma unroll
                for (int j = 0; j < 4; ++j) { s += dot4(v[q][j]); *(u32x2*)(XB + tm_off(r + q, 256 * j + 4 * lane, DM)) = pack4(v[q][j]); }
#pragma unroll
                for (int o = 1; o < 64; o <<= 1) s += __shfl_xor(s, o);
                if (lane < 16) SS[(size_t)(r + q) * 16 + lane] = lane == 0 ? s : 0.f; }
        }
    }
    PHASE_END

    for (int L = 0; L < 4; ++L) {
        const int j = L >> 1;
        if ((L & 1) == 0) {
            bf16_t* wbase = WB + WOFF_MLA + (size_t)j * W_MLA_E;
            PHASE_BEGIN
            { EpiLatIn E{RsSrc{SS, 0, 1, 1.f / DM}, LAT, SSL, KR, a.in[8] + j * 96 + 64, TABM};
              pg8::gemm_phase(ldsl, XB, 1024, wbase, T, 768, 1024, G, bx, E); }
            PHASE_END
            PHASE_BEGIN
            { EpiQ E{RsSrc{SSL, 0, 0, 1.f / QL}, QB, a.in[7] + j * 96, TABM};
              pg8::gemm_phase(ldsl, LAT, 768, wbase + W_IN_E, T, 1536, 384, G, bx, E);
              EpiKV E2{RsSrc{SSL, 8, 0, 1.f / KVL}, KV, a.in[8] + j * 96};
              pg8::gemm_phase(ldsl, LAT + (384 / 64) * 8192, 768, wbase + W_IN_E + W_UQ_E, T, 2048, 256, G, bx, E2); }
            PHASE_END
            PHASE_BEGIN
            {
              const float* qn = a.in[7] + j * 96; const float* kn = a.in[8] + j * 96;
              const float gq1 = gain_absmax(qn, 64, lane), gq2 = gain_absmax(qn + 64, 32, lane), gk1 = gain_absmax(kn, 64, lane), gk2 = gain_absmax(kn + 64, 32, lane);
              const float bound = sqrtf((64.f * gq1 * gq1 + 32.f * gq2 * gq2) * (64.f * gk1 * gk1 + 32.f * gk2 * gk2)) * CQ_MLA;
              const bool nomax = __builtin_amdgcn_readfirstlane(bound <= 40.f ? 1 : 0) != 0;
              if (nomax) att::attn_phase<96, true>(QB, KV, KR, AO, vcu, G, (char*)lds); else att::attn_phase<96, false>(QB, KV, KR, AO, vcu, G, (char*)lds);
            }
            PHASE_END
            PHASE_BEGIN
            { EpiRes E{RsSrc{}, a.out, XB, SS, 0};
              pg8::gemm_phase(ldsl, AO, 1024, wbase + W_IN_E + W_UQ_E + W_UKV_E, T, 1024, 1024, G, bx, E); }
            PHASE_END
        } else {
            bf16_t* wbase = WB + WOFF_GQA + (size_t)j * W_GQA_E;
            PHASE_BEGIN
            { EpiQKV E{RsSrc{SS, 0, 1, 1.f / DM}, QKV, a.in[12] + j * 64, a.in[13] + j * 64, TABG};
              pg8::gemm_phase(ldsl, XB, 1024, wbase, T, 1536, 1024, G, bx, E); }
            PHASE_END
            PHASE_BEGIN
            {
              const float gq = gain_absmax(a.in[12] + j * 64, 64, lane), gk = gain_absmax(a.in[13] + j * 64, 64, lane);
              const float bound = 64.f * gq * gk * CQ_GQA;
              const bool nomax = __builtin_amdgcn_readfirstlane(bound <= 40.f ? 1 : 0) != 0;
              if (nomax) att::attn_phase<64, true>(QKV, nullptr, nullptr, AO, vcu, G, (char*)lds); else att::attn_phase<64, false>(QKV, nullptr, nullptr, AO, vcu, G, (char*)lds);
            }
            PHASE_END
            PHASE_BEGIN
            { EpiRes E{RsSrc{}, a.out, XB, SS, 0};
              pg8::gemm_phase(ldsl, AO, 1024, wbase + W_QKV_E, T, 1024, 1024, G, bx, E); }
            PHASE_END
        }
        bf16_t* wf = WB + WOFF_FFN + (size_t)L * W_FFN_E;
        PHASE_BEGIN
        { EpiGU E{RsSrc{SS, 0, 1, 1.f / DM}, HB};
          pg8::gemm_phase(ldsl, XB, 1024, wf, T, 2 * DFF, 1024, G, bx, E); }
        PHASE_END
        PHASE_BEGIN
        { EpiRes E{RsSrc{}, a.out, XB, SS, L < 3 ? 0 : 1};
          pg8::gemm_phase(ldsl, HB, DFF, wf + W_GU_E, T, 1024, DFF, G, bx, E); }
        PHASE_END
    }
}

extern "C" void kernel_launch(void* const* d_in, const int* in_sizes, int n_in, void* d_out, int out_size, void* d_ws, size_t ws_size, hipStream_t stream) {
    static int grid = 0;
    if (grid == 0) {
        if (n_in != 18 || in_sizes[0] != T * DM || out_size != T * DM || ws_size < WS_END) { fprintf(stderr, "kernel_launch: unexpected shapes (n_in %d in0 %d out %d ws %zu)\n", n_in, n_in > 0 ? in_sizes[0] : -1, out_size, ws_size); grid = -1; return; }
        int dev = 0, cus = 0, per_cu = 0;
        hipGetDevice(&dev); hipDeviceGetAttribute(&cus, hipDeviceAttributeMultiprocessorCount, dev);
        if (hipFuncSetAttribute((const void*)fwd_mega, hipFuncAttributeMaxDynamicSharedMemorySize, LDS_BYTES) != hipSuccess) { fprintf(stderr, "kernel_launch: hipFuncSetAttribute failed\n"); grid = -1; return; }
        if (hipOccupancyMaxActiveBlocksPerMultiprocessor(&per_cu, (const void*)fwd_mega, 512, LDS_BYTES) != hipSuccess || per_cu < 1) { fprintf(stderr, "kernel_launch: occupancy query says %d\n", per_cu); per_cu = 1; }
        (void)hipGetLastError();
        grid = cus * 1;
    }
    if (grid < 0) return;
    Args a{};
    for (int i = 0; i < 18; ++i) a.in[i] = (const float*)d_in[i];
    a.out = (float*)d_out; a.ws = (unsigned char*)d_ws; a.ph_lo = 0; a.ph_hi = N_PHASES;
    if (hipMemsetAsync((char*)d_ws + WS_BAR, 0, BAR_BYTES, stream) != hipSuccess) { fprintf(stderr, "kernel_launch: memset failed\n"); return; }
    void* args[] = {&a};
    hipError_t e = hipLaunchCooperativeKernel((const void*)fwd_mega, dim3(grid), dim3(512), args, LDS_BYTES, stream);
    if (e != hipSuccess) fprintf(stderr, "kernel_launch: cooperative launch failed: %s (grid %d)\n", hipGetErrorString(e), grid);
}
```

```cpp
#include <hip/hip_runtime.h>
#include <hip/hip_cooperative_groups.h>
#include <cstdio>
#include <cstdint>
namespace cg = cooperative_groups;

#define LAS __attribute__((address_space(3)))
typedef unsigned short bf16_t;
typedef short bf16x8 __attribute__((ext_vector_type(8)));
typedef short s16x4 __attribute__((ext_vector_type(4)));
typedef float f32x4 __attribute__((ext_vector_type(4)));
typedef float f32x2 __attribute__((ext_vector_type(2)));
typedef float f32x16 __attribute__((ext_vector_type(16)));
typedef unsigned u32x4 __attribute__((ext_vector_type(4)));
typedef unsigned u32x2 __attribute__((ext_vector_type(2)));
typedef __bf16 bf16x2_t __attribute__((ext_vector_type(2)));

constexpr int T = 65536, DM = 1024, SEQ = 2048, NB = 32;
constexpr int QL = 384, KVL = 256, DFF = 2816;
constexpr float EPS = 1e-6f;
constexpr int NWAVES = 8;
constexpr float CQ_MLA = 0.10206207261596577f * 1.4426950408889634f, CQ_GQA = 0.125f * 1.4426950408889634f;

constexpr size_t MiB = 1u << 20;
constexpr size_t WS_TABM = 0, WS_TABG = 4096;
constexpr size_t WS_SS = 1 * MiB;
constexpr size_t WS_SSL = 5 * MiB;
constexpr size_t WS_KR = 9 * MiB;
constexpr size_t WS_W = 13 * MiB;
constexpr size_t WS_XB = 101 * MiB;
constexpr size_t WS_AO = 229 * MiB;
constexpr size_t WS_B = 357 * MiB;
constexpr size_t WS_KV = 709 * MiB;
constexpr size_t WS_END = 965 * MiB;
constexpr size_t W_IN_E = 768 * 1024, W_UQ_E = 1536 * 384, W_UKV_E = 2048 * 256, W_O_E = 1024 * 1024;
constexpr size_t W_MLA_E = W_IN_E + W_UQ_E + W_UKV_E + W_O_E;
constexpr size_t W_QKV_E = 1536 * 1024, W_GQA_E = W_QKV_E + W_O_E;
constexpr size_t W_GU_E = 5632 * 1024, W_DN_E = 1024 * 2816, W_FFN_E = W_GU_E + W_DN_E;
constexpr size_t WOFF_MLA = 0, WOFF_GQA = 2 * W_MLA_E, WOFF_FFN = WOFF_GQA + 2 * W_GQA_E;
static_assert((WOFF_FFN + 4 * W_FFN_E) * 2 <= 88 * MiB, "weights fit");

__device__ __forceinline__ unsigned cvtpk(float lo, float hi) { f32x2 v = {lo, hi}; bf16x2_t b = __builtin_convertvector(v, bf16x2_t); return __builtin_bit_cast(unsigned, b); }
__device__ __forceinline__ u32x4 pack8(f32x4 a, f32x4 b) { u32x4 w; w.x = cvtpk(a[0], a[1]); w.y = cvtpk(a[2], a[3]); w.z = cvtpk(b[0], b[1]); w.w = cvtpk(b[2], b[3]); return w; }
__device__ __forceinline__ u32x2 pack4(f32x4 a) { u32x2 w; w.x = cvtpk(a[0], a[1]); w.y = cvtpk(a[2], a[3]); return w; }
__device__ __forceinline__ float dot4(f32x4 a) { return (a[0] * a[0] + a[1] * a[1]) + (a[2] * a[2] + a[3] * a[3]); }
__device__ __forceinline__ float rsq(float x) { return __builtin_amdgcn_rsqf(x); }
__device__ __forceinline__ float red_fq(float s) { s += __shfl_xor(s, 16); s += __shfl_xor(s, 32); return s; }
__device__ __forceinline__ float sum16(const float* p) { const f32x4* q = (const f32x4*)p; f32x4 a = q[0] + q[1] + q[2] + q[3]; return (a[0] + a[1]) + (a[2] + a[3]); }


struct RsSrc { const float* p; int off; int two; float inv; };
__device__ __forceinline__ void rs_load(const RsSrc& R, int pm, int tid, f32x4& r0, f32x4& r1) {
    const int row = pm * 256 + (tid >> 1), part = tid & 1;
    const float* b = R.p + (size_t)row * 16 + R.off + (R.two ? 8 : 4) * part;
    r0 = *(const f32x4*)b; r1 = (f32x4){0.f, 0.f, 0.f, 0.f}; if (R.two) r1 = *(const f32x4*)(b + 4);
}
__device__ __forceinline__ void rs_store(const RsSrc& R, LAS float* rs, int tid, f32x4 r0, f32x4 r1) {
    const f32x4 a = r0 + r1; float s = (a[0] + a[1]) + (a[2] + a[3]); s += __shfl_xor(s, 1);
    if ((tid & 1) == 0) rs[tid >> 1] = rsq(s * R.inv + EPS);
}
namespace pg8 {
constexpr int BM = 256, BK = 64, HALF = 128, HTB = HALF * BK * 2, STAGE_BYTES = 8 * HTB, NXCD = 8, WGM = 8;
__host__ __device__ __forceinline__ int lds_byte(int r, int c) { const int st = (r >> 4) * 2 + (c >> 5), rr = r & 15, cc = c & 31, ob = rr * 64 + cc * 2; return st * 1024 + (ob ^ (((ob >> 9) & 1) << 5)); }
__host__ __device__ __forceinline__ void stage_rc(int b, int& R, int& C) { const int st = b / 1024, sb = b % 1024, swz = sb ^ (((sb >> 9) & 1) << 5); R = (st >> 1) * 16 + swz / 64; C = (st & 1) * 32 + (swz % 64) / 2; }
struct Unit { int pm, pn; };
struct StaticOrder {
    int nM, nN, nwg, G, c;
    __device__ void init(int M, int N, int G_, int c_) { nM = M / BM; nN = N / BM; nwg = nM * nN; G = G_; c = c_; }
    __device__ bool next(int i, Unit& u) const {
        const long L = (long)i * G + c; if (L >= nwg) return false;
        int wgid = (int)L; { const int q = nwg / NXCD, r = nwg % NXCD, xcd = wgid % NXCD, off = wgid / NXCD; wgid = (xcd < r ? xcd * (q + 1) : r * (q + 1) + (xcd - r) * q) + off; }
        const int nig = WGM * nN, gid = wgid / nig, fm = gid * WGM, gsz = (nM - fm) < WGM ? (nM - fm) : WGM;
        u.pm = fm + ((wgid % nig) % gsz); u.pn = (wgid % nig) / gsz; return true;
    }
};
template <class Epi>
__device__ __forceinline__ void gemm_phase(LAS unsigned char* lds, const bf16_t* A, const int lda, const bf16_t* Bt, const int M, const int N, const int K, const int G, const int cidx, const Epi& E) {
    int tid = threadIdx.x; asm volatile("" : "+v"(tid));
    const int wid = __builtin_amdgcn_readfirstlane(tid >> 6), lane = tid & 63, wr = wid >> 2, wc = wid & 3, fr = lane & 15, fq = lane >> 4;
    const int nt = K / BK;
    StaticOrder S; S.init(M, N, G, cidx);
    unsigned voffA[2], voffB[2];
#pragma unroll
    for (int i = 0; i < 2; ++i) { int R, C; stage_rc(tid * 16 + i * 8192, R, C); voffA[i] = (unsigned)(R * lda + C) * 2u; voffB[i] = (unsigned)(tid * 16 + i * 8192); }
    const size_t kstep = (size_t)(BK * 2), kstepB = (size_t)HTB;
    const size_t hA = (size_t)HALF * lda * 2, hB = (size_t)(K / BK) * HTB;
    const size_t tA = 2 * hA, tB = 2 * hB;
    const unsigned ldsw = (unsigned)wid * 1024u;
    const int aoff = lds_byte(wr * 64 + fr, fq * 8), boff = lds_byte(wc * 32 + fr, fq * 8);
    LAS float* rsl = (LAS float*)(lds + STAGE_BYTES + 256);
#define PG8_SA(b, h) (((b) * 2 + (h)) * HTB)
#define PG8_SB(b, h) ((4 + (b) * 2 + (h)) * HTB)
#define PG8_STAGE(bufoff, gbase, voff) do { _Pragma("unroll") for (int _i = 0; _i < 2; ++_i) \
        __builtin_amdgcn_global_load_lds((const unsigned*)((const char*)(gbase) + (voff)[_i]), (LAS unsigned*)(lds + (bufoff) + ldsw + _i * 8192), 16, 0, 0); } while (0)
#define PG8_LDA(dst, b, h) do { _Pragma("unroll") for (int m = 0; m < 4; ++m) _Pragma("unroll") for (int k = 0; k < 2; ++k) dst[m][k] = *(const LAS bf16x8*)(lds + PG8_SA(b, h) + aoff + m * 2048 + k * 1024); } while (0)
#define PG8_LDB(dst, b, h) do { _Pragma("unroll") for (int n = 0; n < 2; ++n) _Pragma("unroll") for (int k = 0; k < 2; ++k) dst[n][k] = *(const LAS bf16x8*)(lds + PG8_SB(b, h) + boff + n * 2048 + k * 1024); } while (0)
#define PG8_MMA(ai, bj, At, Bt_) do { __builtin_amdgcn_s_setprio(1); _Pragma("unroll") for (int m = 0; m < 4; ++m) _Pragma("unroll") for (int n = 0; n < 2; ++n) _Pragma("unroll") for (int k = 0; k < 2; ++k) \
        acc[ai][bj][m][n] = __builtin_amdgcn_mfma_f32_16x16x32_bf16(Bt_[n][k], At[m][k], acc[ai][bj][m][n], 0, 0, 0); __builtin_amdgcn_s_setprio(0); } while (0)
#define PG8_WAIT_V(n) asm volatile("s_waitcnt vmcnt(" #n ")" ::: "memory")
#define PG8_WAIT_L(n) asm volatile("s_waitcnt lgkmcnt(" #n ")" ::: "memory")
#define PG8_BAR __builtin_amdgcn_s_barrier()
#define PG8_SCHED __builtin_amdgcn_sched_barrier(0)
    Unit cur, nxt; int ui = 0;
    if (!S.next(0, cur)) return;
    if constexpr (Epi::NEEDS_RS) { f32x4 r0_, r1_; rs_load(E.rsrc, cur.pm, tid, r0_, r1_); rs_store(E.rsrc, rsl, tid, r0_, r1_); }
    f32x4 acc[2][2][4][2];
#pragma unroll
    for (int a = 0; a < 2; ++a)
#pragma unroll
        for (int b = 0; b < 2; ++b)
#pragma unroll
            for (int m = 0; m < 4; ++m)
#pragma unroll
                for (int n = 0; n < 2; ++n) acc[a][b][m][n] = (f32x4){0.f, 0.f, 0.f, 0.f};
    bf16x8 At[4][2], B0[2][2], B1[2][2];
    const char* cA = (const char*)A + (size_t)cur.pm * tA; const char* cB = (const char*)Bt + (size_t)cur.pn * tB;
    PG8_STAGE(PG8_SB(0, 0), cB, voffB); PG8_STAGE(PG8_SB(0, 1), cB + hB, voffB); PG8_STAGE(PG8_SA(0, 0), cA, voffA); PG8_STAGE(PG8_SA(0, 1), cA + hA, voffA);
    if (wr == 1) PG8_BAR;
    PG8_WAIT_V(2); PG8_BAR;
    PG8_STAGE(PG8_SB(1, 0), cB + kstepB, voffB); PG8_STAGE(PG8_SA(1, 0), cA + kstep, voffA); PG8_STAGE(PG8_SB(1, 1), cB + hB + kstepB, voffB);
    PG8_WAIT_V(6); PG8_BAR;
    for (;;) {
        const bool has_next = S.next(ui + 1, nxt);
        const char* nA = has_next ? (const char*)A + (size_t)nxt.pm * tA : cA; const char* nB = has_next ? (const char*)Bt + (size_t)nxt.pn * tB : cB;
#pragma nounroll
        for (int t = 0; t < nt; t += 2) {
            const bool last = (t == nt - 2);
            const char* a1 = cA + (size_t)(t + 1) * kstep;
            const char* a2 = last ? nA : cA + (size_t)(t + 2) * kstep; const char* b2 = last ? nB : cB + (size_t)(t + 2) * kstepB;
            const char* a3 = a2 + kstep; const char* b3 = b2 + kstepB;
            PG8_LDB(B0, 0, 0); PG8_LDB(B1, 0, 1); PG8_SCHED; PG8_LDA(At, 0, 0); PG8_STAGE(PG8_SA(1, 1), a1 + hA, voffA);
            PG8_WAIT_V(8); PG8_WAIT_L(0); PG8_BAR; PG8_MMA(0, 0, At, B0); PG8_MMA(0, 1, At, B1); PG8_BAR; PG8_SCHED;
            PG8_LDA(At, 0, 1); PG8_STAGE(PG8_SB(0, 0), b2, voffB); PG8_STAGE(PG8_SB(0, 1), b2 + hB, voffB); PG8_STAGE(PG8_SA(0, 0), a2, voffA);
            PG8_WAIT_V(8); PG8_WAIT_L(0); PG8_BAR; PG8_MMA(1, 0, At, B0); PG8_MMA(1, 1, At, B1); PG8_BAR; PG8_SCHED;
            PG8_LDB(B0, 1, 0); PG8_LDB(B1, 1, 1); PG8_SCHED; PG8_LDA(At, 1, 0); PG8_STAGE(PG8_SA(0, 1), a2 + hA, voffA);
            PG8_WAIT_V(8); PG8_WAIT_L(0); PG8_BAR; PG8_MMA(0, 0, At, B0); PG8_MMA(0, 1, At, B1); PG8_BAR; PG8_SCHED;
            PG8_LDA(At, 1, 1); PG8_STAGE(PG8_SB(1, 0), b3, voffB); PG8_STAGE(PG8_SB(1, 1), b3 + hB, voffB); PG8_STAGE(PG8_SA(1, 0), a3, voffA);
            PG8_WAIT_V(8); PG8_WAIT_L(0); PG8_BAR; PG8_MMA(1, 0, At, B0); PG8_MMA(1, 1, At, B1); PG8_BAR; PG8_SCHED;
        }
        const int t_ = wid * 64 + fq * 16 + fr;
        if (wr == 0) PG8_BAR;
        f32x4 rs0, rs1; if constexpr (Epi::NEEDS_RS) { if (has_next) rs_load(E.rsrc, nxt.pm, t_, rs0, rs1); }
        E(acc, cur.pm, cur.pn, wr, wc, fr, fq, rsl + (ui & 1) * 256);
        if constexpr (Epi::NEEDS_RS) { if (has_next) rs_store(E.rsrc, rsl + ((ui + 1) & 1) * 256, t_, rs0, rs1); }
        if (!has_next) break;
#pragma unroll
        for (int a = 0; a < 2; ++a)
#pragma unroll
            for (int b = 0; b < 2; ++b)
#pragma unroll
                for (int m = 0; m < 4; ++m)
#pragma unroll
                    for (int n = 0; n < 2; ++n) acc[a][b][m][n] = (f32x4){0.f, 0.f, 0.f, 0.f};
        cur = nxt; cA = nA; cB = nB; ++ui;
        if (wr == 1) PG8_BAR;
    }
    PG8_WAIT_V(0);
    PG8_BAR;
#undef PG8_SA
#undef PG8_SB
#undef PG8_STAGE
#undef PG8_LDA
#undef PG8_LDB
#undef PG8_MMA
#undef PG8_WAIT_V
#undef PG8_WAIT_L
#undef PG8_BAR
#undef PG8_SCHED
}
}

enum { TY_S8 = 0, TY_WIN = 1, TY_WUQ = 2, TY_GQKV = 3, TY_GU = 4 };
__device__ __forceinline__ int pos_s8(int c) { const int g = c >> 6, pn = g >> 2, wc = g & 3, el = c & 63, bj = el >> 5, fq = (el >> 3) & 3, n = (el >> 2) & 1, e = el & 3; return 256 * pn + 128 * bj + 32 * wc + 16 * n + 4 * fq + e; }
__device__ __forceinline__ int dstrow(int type, int c) {
    switch (type) {
    case TY_WIN: {
        if (c < 640) return pos_s8(c);
        const int kc = c - 640, rc = kc >> 4, bj = (kc >> 3) & 1, idx = kc & 7, n = idx >> 2, e = idx & 3;
        return 512 + 128 * bj + 64 + 16 * n + 4 * rc + e; }
    case TY_WUQ: {
        const int h = c / 96, d = c - 96 * h;
        if (d < 64) return pos_s8(64 * h + d);
        const int rd = d - 64, tile = 4 + (h >> 3), wc = (h & 7) >> 1, bj = h & 1, rc = rd >> 4, n = (rd >> 3) & 1, idx = rd & 7, fq = 2 * rc + (idx >> 2), e = idx & 3;
        return 256 * tile + 128 * bj + 32 * wc + 16 * n + 4 * fq + e; }
    case TY_GQKV: {
        const int g = c >> 6;
        if (g >= 20) return pos_s8(c);
        const int pn = g >> 2, wc = g & 3, el = c & 63, rc = el >> 5, bj = (el >> 4) & 1, fq = 2 * rc + ((el >> 3) & 1), n = (el >> 2) & 1, e = el & 3;
        return 256 * pn + 128 * bj + 32 * wc + 16 * n + 4 * fq + e; }
    case TY_GU: {
        const int bj = c >= DFF ? 1 : 0, j = c - bj * DFF, pn = j >> 7, jj = j & 127, wc = jj >> 5, fq = (jj >> 3) & 3, n = (jj >> 2) & 1, e = jj & 3;
        return 256 * pn + 128 * bj + 32 * wc + 16 * n + 4 * fq + e; }
    default: return pos_s8(c);
    }
}

#define EPI_ARGS const f32x4 (&acc)[2][2][4][2], int pm, int pn, int wr, int wc, int fr, int fq, const LAS float* rs
#define RS_ROW (rs[ai * 128 + wr * 64 + m * 16 + fr])
struct EpiRes {
    static constexpr bool NEEDS_RS = false; RsSrc rsrc;
    float* out; bf16_t* xb; float* ss; int final_;
    __device__ __forceinline__ void operator()(EPI_ARGS) const {
        const int g = 4 * pn + wc;
#pragma unroll
        for (int ai = 0; ai < 2; ++ai)
#pragma unroll
            for (int m = 0; m < 4; ++m) {
                asm volatile("" ::: "memory"); const int row = pm * 256 + ai * 128 + wr * 64 + m * 16 + fr; float s = 0.f;
#pragma unroll
                for (int bj = 0; bj < 2; ++bj) {
                    const size_t off = (size_t)row * DM + 64 * g + 32 * bj + 8 * fq;
                    const u32x4 b = *(const u32x4*)(xb + off);
                    const f32x4 b0 = {__uint_as_float(b.x << 16), __uint_as_float(b.x & 0xffff0000u), __uint_as_float(b.y << 16), __uint_as_float(b.y & 0xffff0000u)};
                    const f32x4 b1 = {__uint_as_float(b.z << 16), __uint_as_float(b.z & 0xffff0000u), __uint_as_float(b.w << 16), __uint_as_float(b.w & 0xffff0000u)};
                    const f32x4 v0 = acc[ai][bj][m][0] + b0, v1 = acc[ai][bj][m][1] + b1;
                    if (final_) { *(f32x4*)(out + off) = v0; *(f32x4*)(out + off + 4) = v1; }
                    else { *(u32x4*)(xb + off) = pack8(v0, v1); s += dot4(v0) + dot4(v1); }
                }
                if (!final_) { s = red_fq(s); if (fq == 0) ss[(size_t)row * 16 + g] = s; }
            }
    }
};
struct EpiLatIn {
    static constexpr bool NEEDS_RS = true; RsSrc rsrc;
    bf16_t* lat; float* ssl; bf16_t* kr; const float* knorm  ; const float* tabm;
    __device__ __forceinline__ void operator()(EPI_ARGS) const {
        const int g = 4 * pn + wc;
        if (g == 11) return;
#pragma unroll
        for (int ai = 0; ai < 2; ++ai)
#pragma unroll
            for (int m = 0; m < 4; ++m) {
                asm volatile("" ::: "memory"); const int row = pm * 256 + ai * 128 + wr * 64 + m * 16 + fr;
                const float rstd = RS_ROW;
                if (g < 10) {
                    float s = 0.f;
#pragma unroll
                    for (int bj = 0; bj < 2; ++bj) {
                        const f32x4 v0 = acc[ai][bj][m][0] * rstd, v1 = acc[ai][bj][m][1] * rstd;
                        *(u32x4*)(lat + (size_t)row * 768 + 64 * g + 32 * bj + 8 * fq) = pack8(v0, v1); s += dot4(v0) + dot4(v1);
                    }
                    s = red_fq(s); if (fq == 0) { float* sp = ssl + (size_t)row * 16; sp[g < 6 ? g : g + 2] = s; float z = 0.f; asm volatile("" : "+v"(z)); if (g == 5) { sp[6] = z; sp[7] = z; } if (g == 9) *(f32x4*)(sp + 12) = (f32x4){z, z, z, z}; }
                } else {
                    const bool act = fq < 2; float s = 0.f; f32x4 v[2][2];
#pragma unroll
                    for (int bj = 0; bj < 2; ++bj)
#pragma unroll
                        for (int n = 0; n < 2; ++n) { v[bj][n] = acc[ai][bj][m][n] * rstd; s += act ? dot4(v[bj][n]) : 0.f; }
                    s = red_fq(s);
                    const float r = rsq(s * (1.f / 32.f) + EPS);
                    if (act) {
                        const int t = row & (SEQ - 1), pos = fq == 0 ? (t >> 6) : (t & 63);
#pragma unroll
                        for (int n = 0; n < 2; ++n) {
                            const f32x4 g1 = *(const f32x4*)(knorm + 16 * fq + 4 * n), g2 = *(const f32x4*)(knorm + 16 * fq + 8 + 4 * n);
                            const f32x4 x1 = v[0][n] * r * g1, x2 = v[1][n] * r * g2;
                            const f32x4 cs0 = *(const f32x4*)(tabm + (pos * 8 + 4 * n) * 2), cs1 = *(const f32x4*)(tabm + (pos * 8 + 4 * n) * 2 + 4);
                            const f32x4 c = {cs0[0], cs0[2], cs1[0], cs1[2]}, sn = {cs0[1], cs0[3], cs1[1], cs1[3]};
                            const f32x4 o1 = x1 * c - x2 * sn, o2 = x2 * c + x1 * sn;
                            *(u32x2*)(kr + (size_t)row * 32 + 16 * fq + 4 * n) = pack4(o1);
                            *(u32x2*)(kr + (size_t)row * 32 + 16 * fq + 8 + 4 * n) = pack4(o2);
                        }
                    }
                }
            }
    }
};
struct EpiQ {
    static constexpr bool NEEDS_RS = true; RsSrc rsrc;
    bf16_t* q; const float* qnorm; const float* tabm;
    __device__ __forceinline__ void operator()(EPI_ARGS) const {
        f32x4 gA[2][2];
        if (pn < 4) {
#pragma unroll
            for (int bj = 0; bj < 2; ++bj) { gA[bj][0] = *(const f32x4*)(qnorm + 32 * bj + 8 * fq) * CQ_MLA; gA[bj][1] = *(const f32x4*)(qnorm + 32 * bj + 8 * fq + 4) * CQ_MLA; }
        } else { const int col = 16 * (fq >> 1) + 4 * (fq & 1); gA[0][0] = *(const f32x4*)(qnorm + 64 + col) * CQ_MLA; gA[0][1] = *(const f32x4*)(qnorm + 64 + col + 8) * CQ_MLA; gA[1][0] = gA[0][0]; gA[1][1] = gA[0][1]; }
#pragma unroll
        for (int ai = 0; ai < 2; ++ai)
#pragma unroll
            for (int m = 0; m < 4; ++m) {
                asm volatile("" ::: "memory"); const int row = pm * 256 + ai * 128 + wr * 64 + m * 16 + fr;
                const float rstd = RS_ROW;
                if (pn < 4) {
                    const int h = 4 * pn + wc; float s = 0.f; f32x4 v[2][2];
#pragma unroll
                    for (int bj = 0; bj < 2; ++bj)
#pragma unroll
                        for (int n = 0; n < 2; ++n) { v[bj][n] = acc[ai][bj][m][n] * rstd; s += dot4(v[bj][n]); }
                    s = red_fq(s); const float r = rsq(s * (1.f / 64.f) + EPS);
#pragma unroll
                    for (int bj = 0; bj < 2; ++bj) {
                        const int el = 32 * bj + 8 * fq;
                        *(u32x4*)(q + (size_t)row * 1536 + 96 * h + el) = pack8(v[bj][0] * r * gA[bj][0], v[bj][1] * r * gA[bj][1]);
                    }
                } else {
                    const int t = row & (SEQ - 1), rc = fq >> 1, pos = rc == 0 ? (t >> 6) : (t & 63), i0 = 4 * (fq & 1);
                    const f32x4 cs0 = *(const f32x4*)(tabm + (pos * 8 + i0) * 2), cs1 = *(const f32x4*)(tabm + (pos * 8 + i0) * 2 + 4);
                    const f32x4 c = {cs0[0], cs0[2], cs1[0], cs1[2]}, sn = {cs0[1], cs0[3], cs1[1], cs1[3]};
#pragma unroll
                    for (int bj = 0; bj < 2; ++bj) {
                        const int h = 8 * (pn - 4) + 2 * wc + bj;
                        const f32x4 v1 = acc[ai][bj][m][0] * rstd, v2 = acc[ai][bj][m][1] * rstd;
                        float s = red_fq(dot4(v1) + dot4(v2)); const float r = rsq(s * (1.f / 32.f) + EPS);
                        const int col = 16 * rc + i0;
                        const f32x4 x1 = v1 * r * gA[0][0], x2 = v2 * r * gA[0][1];
                        const f32x4 o1 = x1 * c - x2 * sn, o2 = x2 * c + x1 * sn;
                        bf16_t* dst = q + (size_t)row * 1536 + 96 * h + 64 + col;
                        *(u32x2*)dst = pack4(o1); *(u32x2*)(dst + 8) = pack4(o2);
                    }
                }
            }
    }
};
struct EpiKV {
    static constexpr bool NEEDS_RS = true; RsSrc rsrc;
    bf16_t* kv; const float* knorm;
    __device__ __forceinline__ void operator()(EPI_ARGS) const {
        const int g = 4 * pn + wc; const bool isk = (wc & 1) == 0;
        f32x4 gK[2][2];
#pragma unroll
        for (int bj = 0; bj < 2; ++bj) { gK[bj][0] = (f32x4){1.f, 1.f, 1.f, 1.f}; gK[bj][1] = gK[bj][0];
            if (isk) { gK[bj][0] = *(const f32x4*)(knorm + 32 * bj + 8 * fq); gK[bj][1] = *(const f32x4*)(knorm + 32 * bj + 8 * fq + 4); } }
#pragma unroll
        for (int ai = 0; ai < 2; ++ai)
#pragma unroll
            for (int m = 0; m < 4; ++m) {
                asm volatile("" ::: "memory"); const int row = pm * 256 + ai * 128 + wr * 64 + m * 16 + fr;
                const float rstd = RS_ROW;
                f32x4 v[2][2]; float s = 0.f;
#pragma unroll
                for (int bj = 0; bj < 2; ++bj)
#pragma unroll
                    for (int n = 0; n < 2; ++n) { v[bj][n] = acc[ai][bj][m][n] * rstd; s += dot4(v[bj][n]); }
                float r = 1.f;
                if (isk) { s = red_fq(s); r = rsq(s * (1.f / 64.f) + EPS); }
#pragma unroll
                for (int bj = 0; bj < 2; ++bj) {
                    const int el = 32 * bj + 8 * fq;
                    *(u32x4*)(kv + (size_t)row * 2048 + 64 * g + el) = pack8(v[bj][0] * r * gK[bj][0], v[bj][1] * r * gK[bj][1]);
                }
            }
    }
};
struct EpiQKV {
    static constexpr bool NEEDS_RS = true; RsSrc rsrc;
    bf16_t* qkv; const float* qnorm; const float* knorm; const float* tabg;
    __device__ __forceinline__ void operator()(EPI_ARGS) const {
        const int g = 4 * pn + wc;
        f32x4 gQ[2][2];
        if (g < 20) { const float* gn = g < 16 ? qnorm : knorm; const float sc = g < 16 ? CQ_GQA : 1.f;
#pragma unroll
            for (int n = 0; n < 2; ++n) { gQ[n][0] = *(const f32x4*)(gn + 32 * (fq >> 1) + 8 * (fq & 1) + 4 * n) * sc; gQ[n][1] = *(const f32x4*)(gn + 32 * (fq >> 1) + 8 * (fq & 1) + 4 * n + 16) * sc; } }
#pragma unroll
        for (int ai = 0; ai < 2; ++ai)
#pragma unroll
            for (int m = 0; m < 4; ++m) {
                asm volatile("" ::: "memory"); const int row = pm * 256 + ai * 128 + wr * 64 + m * 16 + fr;
                const float rstd = RS_ROW;
                if (g >= 20) {
#pragma unroll
                    for (int bj = 0; bj < 2; ++bj)
                        *(u32x4*)(qkv + (size_t)row * 1536 + 64 * g + 32 * bj + 8 * fq) = pack8(acc[ai][bj][m][0] * rstd, acc[ai][bj][m][1] * rstd);
                } else {
                    f32x4 v[2][2]; float s = 0.f;
#pragma unroll
                    for (int bj = 0; bj < 2; ++bj)
#pragma unroll
                        for (int n = 0; n < 2; ++n) { v[bj][n] = acc[ai][bj][m][n] * rstd; s += dot4(v[bj][n]); }
                    s = red_fq(s); const float r = rsq(s * (1.f / 64.f) + EPS);
                    const int t = row & (SEQ - 1), pos = (fq >> 1) == 0 ? (t >> 6) : (t & 63);
                    f32x4 o1[2], o2[2];
#pragma unroll
                    for (int n = 0; n < 2; ++n) {
                        const float* tp = tabg + (pos * 16 + 8 * (fq & 1) + 4 * n) * 2;
                        const f32x4 cs0 = *(const f32x4*)tp, cs1 = *(const f32x4*)(tp + 4);
                        const f32x4 c = {cs0[0], cs0[2], cs1[0], cs1[2]}, sn = {cs0[1], cs0[3], cs1[1], cs1[3]};
                        const f32x4 x1 = v[0][n] * r * gQ[n][0], x2 = v[1][n] * r * gQ[n][1];
                        o1[n] = x1 * c - x2 * sn; o2[n] = x2 * c + x1 * sn;
                    }
                    bf16_t* dst = qkv + (size_t)row * 1536 + 64 * g + 32 * (fq >> 1) + 8 * (fq & 1);
                    *(u32x4*)dst = pack8(o1[0], o1[1]); *(u32x4*)(dst + 16) = pack8(o2[0], o2[1]);
                }
            }
    }
};
struct EpiGU {
    static constexpr bool NEEDS_RS = true; RsSrc rsrc;
    bf16_t* h;
    __device__ __forceinline__ void operator()(EPI_ARGS) const {
#pragma unroll
        for (int ai = 0; ai < 2; ++ai)
#pragma unroll
            for (int m = 0; m < 4; ++m) {
                asm volatile("" ::: "memory"); const int row = pm * 256 + ai * 128 + wr * 64 + m * 16 + fr;
                const float rstd = RS_ROW, nrl = -1.4426950408889634f * rstd, r2 = rstd * rstd;
                f32x4 o[2];
#pragma unroll
                for (int n = 0; n < 2; ++n) {
                    const f32x4 ga = acc[ai][0][m][n], gu = ga * acc[ai][1][m][n], ta = ga * nrl;
#pragma unroll
                    for (int e = 0; e < 4; ++e) o[n][e] = gu[e] * (r2 * __builtin_amdgcn_rcpf(1.f + __builtin_amdgcn_exp2f(ta[e])));
                }
                *(u32x4*)(h + (size_t)row * DFF + 128 * pn + 32 * wc + 8 * fq) = pack8(o[0], o[1]);
            }
    }
};

namespace att {
constexpr int QBLK = 32, KVBLK = 64, NT = SEQ / KVBLK;
#define SBAR() __builtin_amdgcn_sched_barrier(0)
__device__ __forceinline__ int crow(int r, int hi) { return (r & 3) + 8 * (r >> 2) + 4 * hi; }
__device__ __forceinline__ int v_st(int k, int c) { const int kk = (k & ~0xC) | ((k & 4) << 1) | ((k & 8) >> 1); return ((kk >> 3) * 2 + (c >> 5)) * 512 + ((kk & 7) * 32 + (c & 31)) * 2; }
__device__ __forceinline__ int v_rd_base(int lane) { return ((lane & 3) << 3) | (((lane >> 2) & 3) << 6) | (((lane >> 4) & 1) << 5) | (((lane >> 5) & 1) << 10); }
constexpr int v_rd_off(int d0, int ks, int half) { return d0 * 512 + ks * 2048 + half * 256; }
template <int OFF> __device__ __forceinline__ s16x4 tr_read(int vb) { s16x4 r; asm volatile("ds_read_b64_tr_b16 %0, %1 offset:%2" : "=&v"(r) : "v"(vb), "i"(OFF) : "memory"); return r; }
#define PKV(L, H) (bf16x8){L[0], L[1], L[2], L[3], H[0], H[1], H[2], H[3]}
template <int KS0, bool SUMV> __device__ __forceinline__ void pv_half(f32x16* o, f32x16& ol, int vb, bf16x8 paA, bf16x8 paB) {
    const bf16x8 ones = {0x3F80, 0x3F80, 0x3F80, 0x3F80, 0x3F80, 0x3F80, 0x3F80, 0x3F80};
    const s16x4 l00 = tr_read<v_rd_off(0, KS0, 0)>(vb), h00 = tr_read<v_rd_off(0, KS0, 1)>(vb), l10 = tr_read<v_rd_off(1, KS0, 0)>(vb), h10 = tr_read<v_rd_off(1, KS0, 1)>(vb);
    const s16x4 l01 = tr_read<v_rd_off(0, KS0 + 1, 0)>(vb), h01 = tr_read<v_rd_off(0, KS0 + 1, 1)>(vb), l11 = tr_read<v_rd_off(1, KS0 + 1, 0)>(vb), h11 = tr_read<v_rd_off(1, KS0 + 1, 1)>(vb);
    asm volatile("s_waitcnt lgkmcnt(0)" ::: "memory"); SBAR();
    o[0] = __builtin_amdgcn_mfma_f32_32x32x16_bf16(paA, PKV(l00, h00), o[0], 0, 0, 0);
    o[1] = __builtin_amdgcn_mfma_f32_32x32x16_bf16(paA, PKV(l10, h10), o[1], 0, 0, 0);
    if constexpr (!SUMV) ol = __builtin_amdgcn_mfma_f32_32x32x16_bf16(paA, ones, ol, 0, 0, 0);
    o[0] = __builtin_amdgcn_mfma_f32_32x32x16_bf16(paB, PKV(l01, h01), o[0], 0, 0, 0);
    o[1] = __builtin_amdgcn_mfma_f32_32x32x16_bf16(paB, PKV(l11, h11), o[1], 0, 0, 0);
    if constexpr (!SUMV) ol = __builtin_amdgcn_mfma_f32_32x32x16_bf16(paB, ones, ol, 0, 0, 0);
}
template <bool SUMV> __device__ __forceinline__ void pv_all(f32x16* o, f32x16& ol, int vb, bf16x8 pa0, bf16x8 pa1, bf16x8 pa2, bf16x8 pa3) { pv_half<0, SUMV>(o, ol, vb, pa0, pa1); pv_half<2, SUMV>(o, ol, vb, pa2, pa3); }
__device__ __forceinline__ float rowmax32(const f32x16& p0, const f32x16& p1) {
    float a = fmaxf(fmaxf(p0[0], p0[1]), p1[0]), b = fmaxf(fmaxf(p0[2], p0[3]), p1[1]); a = fmaxf(fmaxf(a, p1[2]), p1[3]);
#pragma unroll
    for (int r = 4; r < 16; r += 4) { a = fmaxf(fmaxf(a, p0[r]), p0[r + 1]); b = fmaxf(fmaxf(b, p0[r + 2]), p0[r + 3]); a = fmaxf(fmaxf(a, p1[r]), p1[r + 1]); b = fmaxf(fmaxf(b, p1[r + 2]), p1[r + 3]); }
    float m = fmaxf(a, b);
    auto rr = __builtin_amdgcn_permlane32_swap(__float_as_uint(m), __float_as_uint(m), false, false); return fmaxf(__uint_as_float(rr[0]), __uint_as_float(rr[1]));
}
template <bool FIRST, bool NOMAX>
__device__ __forceinline__ void partialSM(f32x16& p0, f32x16& p1, float& m_reg, f32x16& negm, float& alpha) {
    if constexpr (NOMAX) { alpha = 1.f;
#pragma unroll
        for (int r = 0; r < 16; ++r) p0[r] = __builtin_amdgcn_exp2f(p0[r]);
        return; }
    constexpr float THRL = 11.5f;
    const float rm = rowmax32(p0, p1);
    alpha = 1.f;
    if (FIRST || !__builtin_expect(__all(rm <= THRL), 1)) {
        const float dl = FIRST ? rm : fmaxf(rm, 0.f); m_reg += dl;
        if (!FIRST) alpha = __builtin_amdgcn_exp2f(-dl);
        p0 = p0 - dl; p1 = p1 - dl;
#pragma unroll
        for (int r = 0; r < 16; ++r) negm[r] = -m_reg;
    }
    asm volatile("" : "+v"(negm));
#pragma unroll
    for (int r = 0; r < 16; ++r) p0[r] = __builtin_amdgcn_exp2f(p0[r]);
}
template <bool SUMV>
__device__ __forceinline__ void finishSM(f32x16& p0, f32x16& p1, float& l_reg, bf16x8& pa0, bf16x8& pa1, bf16x8& pa2, bf16x8& pa3) {
#pragma unroll
    for (int r = 0; r < 16; ++r) p1[r] = __builtin_amdgcn_exp2f(p1[r]);
    if constexpr (SUMV) {
        float sa = l_reg, sb = 0.f;
#pragma unroll
        for (int r = 0; r < 16; ++r) { sa += p0[r]; sb += p1[r]; }
        l_reg = sa + sb;
    }
#define PK4(P, BASE, OUT) do { const u32x4 w = {cvtpk(P[BASE + 0], P[BASE + 1]), cvtpk(P[BASE + 2], P[BASE + 3]), cvtpk(P[BASE + 4], P[BASE + 5]), cvtpk(P[BASE + 6], P[BASE + 7])}; OUT = __builtin_bit_cast(bf16x8, w); } while (0)
    PK4(p0, 0, pa0); PK4(p0, 8, pa1); PK4(p1, 0, pa2); PK4(p1, 8, pa3);
#undef PK4
}
template <int DK> struct Geo {
    static constexpr int SHM_V = KVBLK * 64 * 2, SHM_K = (DK / 8) * 1024;
    static constexpr int OFF_V = 0, OFF_K = 4 * SHM_V, OFF_WS = OFF_K + 4 * SHM_K, OFF_OST = OFF_WS + NWAVES * 256, BYTES = OFF_OST + NWAVES * 4096;
};
template <int DK, bool NOMAX>
__device__ __forceinline__ void qkt(f32x16& p0, f32x16& p1, const char* Ks, const bf16x8* qr, const f32x16& negm, int r32, int hi) {
#pragma unroll
    for (int d0 = 0; d0 < DK / 16; ++d0) {
        const char* kb = d0 < 4 ? Ks + r32 * 128 + (((2 * d0 + hi) ^ ((r32 >> 1) & 7)) << 4) : Ks + 8192 + r32 * 64 + (((2 * (d0 - 4) + hi) ^ ((r32 >> 2) & 3)) << 4);
        const bf16x8 b0 = *reinterpret_cast<const bf16x8*>(kb);
        const bf16x8 b1 = *reinterpret_cast<const bf16x8*>(kb + (d0 < 4 ? 4096 : 2048));
        if (d0 == 0) { if constexpr (NOMAX) { p0 = __builtin_amdgcn_mfma_f32_32x32x16_bf16(b0, qr[0], f32x16{}, 0, 0, 0); p1 = __builtin_amdgcn_mfma_f32_32x32x16_bf16(b1, qr[0], f32x16{}, 0, 0, 0); }
                       else { p0 = __builtin_amdgcn_mfma_f32_32x32x16_bf16(b0, qr[0], negm, 0, 0, 0); p1 = __builtin_amdgcn_mfma_f32_32x32x16_bf16(b1, qr[0], negm, 0, 0, 0); } }
        else { p0 = __builtin_amdgcn_mfma_f32_32x32x16_bf16(b0, qr[d0], p0, 0, 0, 0); p1 = __builtin_amdgcn_mfma_f32_32x32x16_bf16(b1, qr[d0], p1, 0, 0, 0); } }
}
template <int DK, bool NOMAX>
__device__ __forceinline__ void attn_phase(const bf16_t* __restrict__ Qbuf, const bf16_t* __restrict__ KVbuf, const bf16_t* __restrict__ KRbuf, bf16_t* __restrict__ AObuf, const int vcu, const int G_, char* lds) {
    using G = Geo<DK>; constexpr int SHM_V = G::SHM_V, SHM_K = G::SHM_K, ND = DK / 16, NU = NB * 16 * 8;
    constexpr int ldq = 1536, ldk = (DK == 96) ? 2048 : 1536, ldv = ldk, ldo = 1024;
    int tid = threadIdx.x; asm volatile("" : "+v"(tid));
    const int wid = __builtin_amdgcn_readfirstlane(tid >> 6), lane = tid & 63, r32 = lane & 31, hi = lane >> 5;
    char* V_lds = lds + G::OFF_V; char* K_lds = lds + G::OFF_K;
    float* al_l = (float*)(lds + G::OFF_WS) + wid * 64;
    const bool xk = (DK == 96) && (wid < 4);
    const int vb0 = (int)(uintptr_t)V_lds + v_rd_base(lane);
    LAS unsigned char* ldsl = (LAS unsigned char*)lds;
    const int vkk = 8 * wid + ((lane & 31) >> 2), vk = (vkk & ~0xC) | ((vkk & 4) << 1) | ((vkk & 8) >> 1);
    const int kr_ = 8 * wid + (lane >> 3), kr2_ = 16 * wid + (lane >> 2);
    const unsigned koff = (unsigned)(kr_ * ldk + (((lane & 7) ^ ((kr_ >> 1) & 7)) << 3)) * 2u, k2off = (unsigned)(kr2_ * 32 + (((lane & 3) ^ ((kr2_ >> 2) & 3)) << 3)) * 2u, voff = (unsigned)(vk * ldv + 32 * (lane >> 5) + 8 * (lane & 3)) * 2u;
#define UDEC(u_, Qp, Kp, K2p, Vp, Op) do { const int bh_ = (u_) >> 3, qb_ = (u_) & 7, b_ = bh_ >> 4, h_ = bh_ & 15; const size_t r0_ = (size_t)b_ * SEQ; \
        if (DK == 96) { Qp = Qbuf + (r0_ + qb_ * 256) * 1536 + h_ * 96; Kp = KVbuf + r0_ * 2048 + h_ * 128; K2p = KRbuf + r0_ * 32; Vp = KVbuf + r0_ * 2048 + h_ * 128 + 64; } \
        else { Qp = Qbuf + (r0_ + qb_ * 256) * 1536 + h_ * 64; Kp = Qbuf + r0_ * 1536 + 1024 + (h_ >> 2) * 64; K2p = Kp; Vp = Qbuf + r0_ * 1536 + 1280 + (h_ >> 2) * 64; } \
        Op = AObuf + (r0_ + qb_ * 256) * 1024 + h_ * 64; } while (0)
#define GLDS(src, off) __builtin_amdgcn_global_load_lds((const unsigned*)(src), (LAS unsigned*)(ldsl + (off)), 16, 0, 0)
#define DMA_K(kp, k2p, t, sl) do { GLDS((const char*)((kp) + (size_t)(t) * KVBLK * ldk) + koff, G::OFF_K + (sl) * SHM_K + wid * 1024); if (xk) GLDS((const char*)((k2p) + (size_t)(t) * KVBLK * 32) + k2off, G::OFF_K + (sl) * SHM_K + (8 + wid) * 1024); } while (0)
#define DMA_V(vp, t, sl) GLDS((const char*)((vp) + (size_t)(t) * KVBLK * ldv) + voff, G::OFF_V + (sl) * SHM_V + wid * 1024)
#define WAITBAR(N) asm volatile("s_waitcnt vmcnt(" #N ") lgkmcnt(0)\n\ts_barrier" ::: "memory")
#define WAITBAR_C() do { if (xk) WAITBAR(3); else WAITBAR(2); } while (0)
#define RESC(a) do { if (__any((a) < 1.f)) { if (hi == 0) al_l[r32] = (a); asm volatile("s_waitcnt lgkmcnt(0)" ::: "memory"); \
    _Pragma("unroll") for (int r = 0; r < 16; ++r) { const float f_ = al_l[crow(r, hi)]; o[0][r] *= f_; o[1][r] *= f_; ol[r] *= f_; } } } while (0)
#define ROT3() do { const int t_ = sA; sA = sB; sB = sC; sC = t_; } while (0)
    int u = vcu; if (u >= NU) return;
    const bf16_t *Qc, *kC, *k2C, *vC; bf16_t* Oc; UDEC(u, Qc, kC, k2C, vC, Oc);
    bf16x8 qr[ND];
    { const bf16_t* Qw = Qc + (size_t)(wid * QBLK + r32) * ldq + hi * 8;
#pragma unroll
      for (int d0 = 0; d0 < ND; ++d0) qr[d0] = *reinterpret_cast<const bf16x8*>(Qw + d0 * 16); }
    DMA_K(kC, k2C, 0, 0); DMA_V(vC, 0, 0); DMA_K(kC, k2C, 1, 1);
    WAITBAR(0);
    for (;;) {
        const int un = u + G_; const bool has_next = un < NU;
        float m_reg = 0.f, l_reg = 0.f; f32x16 o[2] = {}; f32x16 ol = {}; f32x16 negm = {}; asm volatile("" : "+v"(negm));
        f32x16 pA0, pA1, pB0, pB1; float alA, alB; bf16x8 pa0, pa1, pa2, pa3;
#define SDMA(j) do {   \
        if ((j) + 2 < NT) { DMA_K(kC, k2C, (j) + 2, ((j) + 2) & 3); DMA_K(kC, k2C, (j) + 3, ((j) + 3) & 3); DMA_V(vC, (j) + 1, ((j) + 1) & 3); DMA_V(vC, (j) + 2, ((j) + 2) & 3); } \
        else { DMA_V(vC, (j) + 1, ((j) + 1) & 3); if (has_next) { const bf16_t *Qn, *kN, *k2N, *vN; bf16_t* On; UDEC(un, Qn, kN, k2N, vN, On); (void)Qn; (void)On; DMA_K(kN, k2N, 0, 0); DMA_K(kN, k2N, 1, 1); DMA_V(vN, 0, 0); } } } while (0)
#define STEP(PC0, PC1, PP0, PP1, alC, j) do { SBAR(); \
        qkt<DK, NOMAX>(PC0, PC1, K_lds + ((j) & 3) * SHM_K, qr, negm, r32, hi); \
        finishSM<NOMAX>(PP0, PP1, l_reg, pa0, pa1, pa2, pa3); SBAR(); \
        pv_all<NOMAX>(o, ol, vb0 + (((j) - 1) & 3) * SHM_V, pa0, pa1, pa2, pa3); partialSM<false, NOMAX>(PC0, PC1, m_reg, negm, alC); \
        if constexpr (!NOMAX) RESC(alC); SBAR(); } while (0)
        SDMA(0);
        qkt<DK, NOMAX>(pA0, pA1, K_lds, qr, negm, r32, hi); partialSM<true, NOMAX>(pA0, pA1, m_reg, negm, alA);
        STEP(pB0, pB1, pA0, pA1, alB, 1); WAITBAR(0);
        for (int j = 2; j < NT; j += 2) {
            SBAR(); SDMA(j); SBAR();
            STEP(pA0, pA1, pB0, pB1, alA, j);
            STEP(pB0, pB1, pA0, pA1, alB, j + 1); WAITBAR(0);
        }
#undef STEP
#undef SDMA
        finishSM<NOMAX>(pB0, pB1, l_reg, pa0, pa1, pa2, pa3); SBAR();
        if (has_next) { const bf16_t *Qn, *kN, *k2N, *vN; bf16_t* On; UDEC(un, Qn, kN, k2N, vN, On); (void)kN; (void)k2N; (void)vN; (void)On; const bf16_t* Qw = Qn + (size_t)(wid * QBLK + r32) * ldq + hi * 8;
#pragma unroll
            for (int d0 = 0; d0 < ND; ++d0) qr[d0] = *reinterpret_cast<const bf16x8*>(Qw + d0 * 16); }
        pv_all<NOMAX>(o, ol, vb0 + ((NT - 1) & 3) * SHM_V, pa0, pa1, pa2, pa3);
        bf16_t* Ow = Oc + (size_t)(wid * QBLK) * ldo;
        { bf16_t* stg = (bf16_t*)(lds + G::OFF_OST) + wid * 2048;
          if constexpr (NOMAX) { auto rr = __builtin_amdgcn_permlane32_swap(__float_as_uint(l_reg), __float_as_uint(l_reg), false, false); l_reg = __uint_as_float(rr[0]) + __uint_as_float(rr[1]);
              if (hi == 0) al_l[r32] = l_reg; asm volatile("s_waitcnt lgkmcnt(0)" ::: "memory");
#pragma unroll
              for (int r = 0; r < 16; ++r) ol[r] = al_l[crow(r, hi)]; }
#pragma unroll
          for (int r = 0; r < 16; ++r) { const int orow = crow(r, hi); const float rl = __builtin_amdgcn_rcpf(ol[r]);
#pragma unroll
            for (int d0 = 0; d0 < 2; ++d0) stg[orow * 64 + d0 * 32 + r32] = (bf16_t)(cvtpk(o[d0][r] * rl, 0.f) & 0xffffu); }
          asm volatile("s_waitcnt lgkmcnt(0)" ::: "memory");
#pragma unroll
          for (int i = 0; i < 4; ++i) { const int row = i * 8 + (lane >> 3), ch = lane & 7; const u32x4 v = *(const u32x4*)(stg + row * 64 + ch * 8); *(u32x4*)(Ow + (size_t)row * ldo + ch * 8) = v; } }
        if (!has_next) break;
        u = un; UDEC(u, Qc, kC, k2C, vC, Oc);
    }
    asm volatile("s_waitcnt vmcnt(0) lgkmcnt(0)" ::: "memory"); __syncthreads();
#undef UDEC
#undef GLDS
#undef DMA_K
#undef DMA_V
#undef WAITBAR
#undef WAITBAR_C
#undef RESC
#undef ROT3
}
}

__device__ __forceinline__ void transpose_item(const float* W, int K, int N, const float* gain, bf16_t* WT, int type, LAS float* scr, int item, int lane) {
    const int nblk = N / 32, kb = item / nblk, nb = item % nblk, k0 = 64 * kb, n0 = 32 * nb;
    const int kr = lane >> 3, nc = (lane & 7) * 4;
    f32x4 v[8];
#pragma unroll
    for (int i = 0; i < 8; ++i) v[i] = *(const f32x4*)(W + (size_t)(k0 + 8 * i + kr) * N + n0 + nc);
#pragma unroll
    for (int i = 0; i < 8; ++i) { const int kk = 8 * i + kr; const float gv = gain ? gain[k0 + kk] : 1.f; LAS float* d = scr + kk * 33 + nc;
        d[0] = v[i][0] * gv; d[1] = v[i][1] * gv; d[2] = v[i][2] * gv; d[3] = v[i][3] * gv; }
    asm volatile("s_waitcnt lgkmcnt(0)" ::: "memory");
    const int c = lane & 7;
#pragma unroll
    for (int j = 0; j < 4; ++j) { const int n = (lane >> 3) + 8 * j; const LAS float* s = scr + (8 * c) * 33 + n;
        u32x4 o; o.x = cvtpk(s[0 * 33], s[1 * 33]); o.y = cvtpk(s[2 * 33], s[3 * 33]); o.z = cvtpk(s[4 * 33], s[5 * 33]); o.w = cvtpk(s[6 * 33], s[7 * 33]);
        { const int pos_ = dstrow(type, n0 + n); *(u32x4*)((char*)WT + ((size_t)(pos_ >> 7) * (K / 64) + (k0 >> 6)) * pg8::HTB + pg8::lds_byte(pos_ & 127, 8 * c)) = o; } }
    asm volatile("s_waitcnt lgkmcnt(0)" ::: "memory");
}
struct MatInfo { const float* W; const float* gain; bf16_t* WT; int K, N, type; };

struct Args { const float* in[18]; float* out; unsigned char* ws; int ph_lo, ph_hi; };

__device__ __forceinline__ MatInfo mat_info(const Args& a, int mi) {
    MatInfo r; bf16_t* wb = (bf16_t*)(a.ws + WS_W);
    if (mi < 8) { const int j = mi >> 2, w = mi & 3; bf16_t* base = wb + WOFF_MLA + (size_t)j * W_MLA_E;
        if (w == 0) { r.W = a.in[2] + (size_t)j * 1024 * 672; r.gain = a.in[1] + j * 1024; r.WT = base; r.K = 1024; r.N = 672; r.type = TY_WIN; }
        else if (w == 1) { r.W = a.in[4] + (size_t)j * 384 * 1536; r.gain = a.in[3] + j * 384; r.WT = base + W_IN_E; r.K = 384; r.N = 1536; r.type = TY_WUQ; }
        else if (w == 2) { r.W = a.in[6] + (size_t)j * 256 * 2048; r.gain = a.in[5] + j * 256; r.WT = base + W_IN_E + W_UQ_E; r.K = 256; r.N = 2048; r.type = TY_S8; }
        else { r.W = a.in[9] + (size_t)j * 1024 * 1024; r.gain = nullptr; r.WT = base + W_IN_E + W_UQ_E + W_UKV_E; r.K = 1024; r.N = 1024; r.type = TY_S8; }
    } else if (mi < 12) { const int j = (mi - 8) >> 1, w = (mi - 8) & 1; bf16_t* base = wb + WOFF_GQA + (size_t)j * W_GQA_E;
        if (w == 0) { r.W = a.in[11] + (size_t)j * 1024 * 1536; r.gain = a.in[10] + j * 1024; r.WT = base; r.K = 1024; r.N = 1536; r.type = TY_GQKV; }
        else { r.W = a.in[14] + (size_t)j * 1024 * 1024; r.gain = nullptr; r.WT = base + W_QKV_E; r.K = 1024; r.N = 1024; r.type = TY_S8; }
    } else { const int i = (mi - 12) >> 1, w = (mi - 12) & 1; bf16_t* base = wb + WOFF_FFN + (size_t)i * W_FFN_E;
        if (w == 0) { r.W = a.in[16] + (size_t)i * 1024 * 5632; r.gain = a.in[15] + i * 1024; r.WT = base; r.K = 1024; r.N = 5632; r.type = TY_GU; }
        else { r.W = a.in[17] + (size_t)i * 2816 * 1024; r.gain = nullptr; r.WT = base + W_GU_E; r.K = 2816; r.N = 1024; r.type = TY_S8; }
    }
    return r;
}


constexpr size_t WS_BAR = 16384, BAR_BYTES = 16384;
#define XB_TMO      128
#define XB_XCNT(j)  (256  + 64 * (j))
#define XB_XSUB(j)  (1280 + 64 * (j))
#define XB_XGEN(j)  (2304 + 64 * (j))
#define XB_TOP      3328
#define XB_TOPGEN   3392
#define XB_SPIN_CAP (1u << 22)
__device__ __forceinline__ unsigned xb_ld(unsigned* p)              { return __hip_atomic_load(p, __ATOMIC_RELAXED, __HIP_MEMORY_SCOPE_AGENT); }
__device__ __forceinline__ unsigned xb_add(unsigned* p, unsigned v) { return __hip_atomic_fetch_add(p, v, __ATOMIC_RELAXED, __HIP_MEMORY_SCOPE_AGENT); }
__device__ __forceinline__ unsigned xb_xcc_id() { return (unsigned)__builtin_amdgcn_s_getreg((3 << 11) | 20) & 0xFu; }
#define XB_SPIN(cond, bar) do { unsigned _sp = 0; while (cond) { __builtin_amdgcn_s_sleep(1); \
    if ((++_sp & 255u) == 0u) { if (xb_ld(&(bar)[XB_TMO])) break; if (_sp > XB_SPIN_CAP) { atomicAdd(&(bar)[XB_TMO], 1u); break; } } } } while (0)
struct XcdBarrier { unsigned* bar; unsigned x; volatile LAS unsigned* st; };
__device__ __forceinline__ XcdBarrier xcd_barrier_post(unsigned* bar, volatile LAS unsigned* st) {
    XcdBarrier b; b.bar = bar; b.x = xb_xcc_id(); b.st = st;
    if (threadIdx.x == 0) (void)xb_add(&bar[XB_XCNT(b.x)], 1u);
    return b;
}
__device__ __forceinline__ void xcd_barrier_complete(unsigned* bar, unsigned x, unsigned& nloc, unsigned& nx) {
    const unsigned G = gridDim.x * gridDim.y * gridDim.z;
    unsigned sum, cnt, mine, sp = 0u;
    for (;;) {
        sum = 0u; cnt = 0u; mine = 0u;
#pragma unroll
        for (unsigned j = 0; j < 16; ++j) { const unsigned c = xb_ld(&bar[XB_XCNT(j)]); sum += c; cnt += (c > 0u) ? 1u : 0u; mine = (j == x) ? c : mine; }
        if (sum == G) break;
        __builtin_amdgcn_s_sleep(1);
        if ((++sp & 255u) == 0u) { if (xb_ld(&bar[XB_TMO])) break; if (sp > XB_SPIN_CAP) { atomicAdd(&bar[XB_TMO], 1u); break; } }
    }
    nloc = mine > 0u ? mine : 1u; nx = cnt > 0u ? cnt : 1u;
}
__device__ __forceinline__ void xcd_barrier(const XcdBarrier& b) {
    asm volatile("s_waitcnt vmcnt(0)" ::: "memory");
    __syncthreads();
    if (threadIdx.x == 0) {
        unsigned* bar = b.bar;
        __builtin_amdgcn_s_waitcnt(0);
        unsigned nloc = b.st[0], nx = b.st[1];
        if (nloc == 0u) { xcd_barrier_complete(bar, b.x, nloc, nx); b.st[0] = nloc; b.st[1] = nx; }
        const unsigned old = xb_add(&bar[XB_XSUB(b.x)], 1u);
        const unsigned gen = old / nloc;
        if (old + 1u == (gen + 1u) * nloc) {
            __builtin_amdgcn_fence(__ATOMIC_RELEASE, "agent");
            asm volatile("s_waitcnt vmcnt(0)" ::: "memory");
            const unsigned og = xb_add(&bar[XB_TOP], 1u);
            const unsigned tg = og / nx;
            if (og + 1u == (tg + 1u) * nx) xb_add(&bar[XB_TOPGEN], 1u);
            else XB_SPIN(xb_ld(&bar[XB_TOPGEN]) == tg, bar);
            __builtin_amdgcn_fence(__ATOMIC_ACQUIRE, "agent");
            xb_add(&bar[XB_XGEN(b.x)], 1u);
            asm volatile("s_waitcnt vmcnt(0)" ::: "memory");
        } else {
            XB_SPIN(xb_ld(&bar[XB_XGEN(b.x)]) == gen, bar);
            __builtin_amdgcn_fence(__ATOMIC_ACQUIRE, "agent");
            asm volatile("s_waitcnt vmcnt(0)" ::: "memory");
        }
    }
    __syncthreads();
}
__device__ __forceinline__ float gain_absmax(const float* g, int n, int lane) {
    asm volatile("" : "+v"(lane));
    float v = lane < n ? fabsf(g[lane]) : 0.f;
#pragma unroll
    for (int o = 1; o < 64; o <<= 1) v = fmaxf(v, __shfl_xor(v, o));
    return v;
}
constexpr int LDS_BYTES = 147456;
constexpr int N_PHASES = 1 + 6 + 5 + 6 + 5;
__global__ void __launch_bounds__(512, 2) fwd_mega(Args a) {
    extern __shared__ __attribute__((aligned(16))) unsigned char lds[];
    cg::grid_group grid = cg::this_grid();
    const int tid = threadIdx.x, lane = tid & 63, wave = __builtin_amdgcn_readfirstlane(tid >> 6);
    const int G = gridDim.x, bx = blockIdx.x;
    const int vcu = (G % 8 == 0) ? (bx % 8) * (G / 8) + bx / 8 : bx;
    LAS unsigned char* ldsl = (LAS unsigned char*)lds;
    unsigned char* ws = a.ws;
    float* SS = (float*)(ws + WS_SS); float* SSL = (float*)(ws + WS_SSL);
    bf16_t* KR = (bf16_t*)(ws + WS_KR); bf16_t* XB = (bf16_t*)(ws + WS_XB); bf16_t* AO = (bf16_t*)(ws + WS_AO);
    bf16_t* HB = (bf16_t*)(ws + WS_B); bf16_t* LAT = HB; bf16_t* QB = (bf16_t*)(ws + WS_B + 96 * MiB); bf16_t* QKV = HB;
    bf16_t* KV = (bf16_t*)(ws + WS_KV);
    const float* TABM = (const float*)(ws + WS_TABM); const float* TABG = (const float*)(ws + WS_TABG);
    bf16_t* WB = (bf16_t*)(ws + WS_W);
    const int lo = a.ph_lo, hi = a.ph_hi;
    int ph = 0;
    volatile LAS unsigned* MISC = (volatile LAS unsigned*)(ldsl + 131072);
    if (tid < 4) MISC[tid] = 0u;
    __syncthreads();
    XcdBarrier xbar = xcd_barrier_post((unsigned*)(ws + WS_BAR), MISC);
#define PHASE_BEGIN if (lo <= ph && ph < hi) {
#define PHASE_END   if (ph + 1 < hi) { if (ph == 0) grid.sync(); else xcd_barrier(xbar); } } ++ph;

    PHASE_BEGIN
    {
        LAS float* scr = (LAS float*)(ldsl + wave * 16384);
        const int gw = vcu * NWAVES + wave, NGW = G * NWAVES;
        int base = 0;
        for (int mi = 0; mi < 20; ++mi) {
            const MatInfo mt = mat_info(a, mi); const int items = (mt.K / 64) * (mt.N / 32);
            int first = (gw - base % NGW + NGW) % NGW;
            for (int it = first; it < items; it += NGW) transpose_item(mt.W, mt.K, mt.N, mt.gain, mt.WT, mt.type, scr, it, lane);
            base += items;
        }
        for (int j = 0; j < 2; ++j) { bf16_t* wt = WB + WOFF_MLA + (size_t)j * W_MLA_E;
            for (int idx = gw; idx < 256; idx += NGW) { const int p = idx, wc = (p >> 5) & 3, fq = (p >> 2) & 3;
                if (wc == 3 || (wc == 2 && fq >= 2)) { u32x4 z = {0u, 0u, 0u, 0u}; const int pos_ = 512 + p; for (int k = lane * 8; k < 1024; k += 512) *(u32x4*)((char*)wt + ((size_t)(pos_ >> 7) * 16 + (k >> 6)) * pg8::HTB + pg8::lds_byte(pos_ & 127, k & 63)) = z; } } }
        { const int gt = bx * 512 + tid;
          if (gt < 512) { const int pos = gt >> 3, j = gt & 7; const float inv = exp2f(-(float)j * (13.287712379549449f / 8.f)); const float ang = (float)pos * inv;
              ((float*)(ws + WS_TABM))[gt * 2] = cosf(ang); ((float*)(ws + WS_TABM))[gt * 2 + 1] = sinf(ang); }
          else if (gt < 512 + 1024) { const int i = gt - 512, pos = i >> 4, j = i & 15; const float inv = exp2f(-(float)j * (13.287712379549449f / 16.f)); const float ang = (float)pos * inv;
              ((float*)(ws + WS_TABG))[i * 2] = cosf(ang); ((float*)(ws + WS_TABG))[i * 2 + 1] = sinf(ang); } }
        for (int r = gw * 4; r < T; r += NGW * 4) {
            f32x4 v[4][4];
#pragma unroll
            for (int q = 0; q < 4; ++q)
#pragma unroll
                for (int j = 0; j < 4; ++j) v[q][j] = ((const f32x4*)(a.in[0] + (size_t)(r + q) * DM) + lane)[64 * j];
#pragma unroll
            for (int q = 0; q < 4; ++q) { float s = 0.f;
#pragma unroll
                for (int j = 0; j < 4; ++j) { s += dot4(v[q][j]); *(u32x2*)(XB + (size_t)(r + q) * DM + 256 * j + 4 * lane) = pack4(v[q][j]); }
#pragma unroll
                for (int o = 1; o < 64; o <<= 1) s += __shfl_xor(s, o);
                if (lane < 16) SS[(size_t)(r + q) * 16 + lane] = lane == 0 ? s : 0.f; }
        }
    }
    PHASE_END

    for (int L = 0; L < 4; ++L) {
        const int j = L >> 1;
        if ((L & 1) == 0) {
            bf16_t* wbase = WB + WOFF_MLA + (size_t)j * W_MLA_E;
            PHASE_BEGIN
            { EpiLatIn E{RsSrc{SS, 0, 1, 1.f / DM}, LAT, SSL, KR, a.in[8] + j * 96 + 64, TABM};
              pg8::gemm_phase(ldsl, XB, 1024, wbase, T, 768, 1024, G, bx, E); }
            PHASE_END
            PHASE_BEGIN
            { EpiQ E{RsSrc{SSL, 0, 0, 1.f / QL}, QB, a.in[7] + j * 96, TABM};
              pg8::gemm_phase(ldsl, LAT, 768, wbase + W_IN_E, T, 1536, 384, G, bx, E);
              EpiKV E2{RsSrc{SSL, 8, 0, 1.f / KVL}, KV, a.in[8] + j * 96};
              pg8::gemm_phase(ldsl, LAT + 384, 768, wbase + W_IN_E + W_UQ_E, T, 2048, 256, G, bx, E2); }
            PHASE_END
            PHASE_BEGIN
            {
              const float* qn = a.in[7] + j * 96; const float* kn = a.in[8] + j * 96;
              const float gq1 = gain_absmax(qn, 64, lane), gq2 = gain_absmax(qn + 64, 32, lane), gk1 = gain_absmax(kn, 64, lane), gk2 = gain_absmax(kn + 64, 32, lane);
              const float bound = sqrtf((64.f * gq1 * gq1 + 32.f * gq2 * gq2) * (64.f * gk1 * gk1 + 32.f * gk2 * gk2)) * CQ_MLA;
              const bool nomax = __builtin_amdgcn_readfirstlane(bound <= 40.f ? 1 : 0) != 0;
              if (nomax) att::attn_phase<96, true>(QB, KV, KR, AO, vcu, G, (char*)lds); else att::attn_phase<96, false>(QB, KV, KR, AO, vcu, G, (char*)lds);
            }
            PHASE_END
            PHASE_BEGIN
            { EpiRes E{RsSrc{}, a.out, XB, SS, 0};
              pg8::gemm_phase(ldsl, AO, 1024, wbase + W_IN_E + W_UQ_E + W_UKV_E, T, 1024, 1024, G, bx, E); }
            PHASE_END
        } else {
            bf16_t* wbase = WB + WOFF_GQA + (size_t)j * W_GQA_E;
            PHASE_BEGIN
            { EpiQKV E{RsSrc{SS, 0, 1, 1.f / DM}, QKV, a.in[12] + j * 64, a.in[13] + j * 64, TABG};
              pg8::gemm_phase(ldsl, XB, 1024, wbase, T, 1536, 1024, G, bx, E); }
            PHASE_END
            PHASE_BEGIN
            {
              const float gq = gain_absmax(a.in[12] + j * 64, 64, lane), gk = gain_absmax(a.in[13] + j * 64, 64, lane);
              const float bound = 64.f * gq * gk * CQ_GQA;
              const bool nomax = __builtin_amdgcn_readfirstlane(bound <= 40.f ? 1 : 0) != 0;
              if (nomax) att::attn_phase<64, true>(QKV, nullptr, nullptr, AO, vcu, G, (char*)lds); else att::attn_phase<64, false>(QKV, nullptr, nullptr, AO, vcu, G, (char*)lds);
            }
            PHASE_END
            PHASE_BEGIN
            { EpiRes E{RsSrc{}, a.out, XB, SS, 0};
              pg8::gemm_phase(ldsl, AO, 1024, wbase + W_QKV_E, T, 1024, 1024, G, bx, E); }
            PHASE_END
        }
        bf16_t* wf = WB + WOFF_FFN + (size_t)L * W_FFN_E;
        PHASE_BEGIN
        { EpiGU E{RsSrc{SS, 0, 1, 1.f / DM}, HB};
          pg8::gemm_phase(ldsl, XB, 1024, wf, T, 2 * DFF, 1024, G, bx, E); }
        PHASE_END
        PHASE_BEGIN
        { EpiRes E{RsSrc{}, a.out, XB, SS, L < 3 ? 0 : 1};
          pg8::gemm_phase(ldsl, HB, DFF, wf + W_GU_E, T, 1024, DFF, G, bx, E); }
        PHASE_END
    }
}

extern "C" void kernel_launch(void* const* d_in, const int* in_sizes, int n_in, void* d_out, int out_size, void* d_ws, size_t ws_size, hipStream_t stream) {
    static int grid = 0;
    if (grid == 0) {
        if (n_in != 18 || in_sizes[0] != T * DM || out_size != T * DM || ws_size < WS_END) { fprintf(stderr, "kernel_launch: unexpected shapes (n_in %d in0 %d out %d ws %zu)\n", n_in, n_in > 0 ? in_sizes[0] : -1, out_size, ws_size); grid = -1; return; }
        int dev = 0, cus = 0, per_cu = 0;
        hipGetDevice(&dev); hipDeviceGetAttribute(&cus, hipDeviceAttributeMultiprocessorCount, dev);
        if (hipFuncSetAttribute((const void*)fwd_mega, hipFuncAttributeMaxDynamicSharedMemorySize, LDS_BYTES) != hipSuccess) { fprintf(stderr, "kernel_launch: hipFuncSetAttribute failed\n"); grid = -1; return; }
        if (hipOccupancyMaxActiveBlocksPerMultiprocessor(&per_cu, (const void*)fwd_mega, 512, LDS_BYTES) != hipSuccess || per_cu < 1) { fprintf(stderr, "kernel_launch: occupancy query says %d\n", per_cu); per_cu = 1; }
        (void)hipGetLastError();
        grid = cus * 1;
    }
    if (grid < 0) return;
    Args a{};
    for (int i = 0; i < 18; ++i) a.in[i] = (const float*)d_in[i];
    a.out = (float*)d_out; a.ws = (unsigned char*)d_ws; a.ph_lo = 0; a.ph_hi = N_PHASES;
    if (hipMemsetAsync((char*)d_ws + WS_BAR, 0, BAR_BYTES, stream) != hipSuccess) { fprintf(stderr, "kernel_launch: memset failed\n"); return; }
    void* args[] = {&a};
    hipError_t e = hipLaunchCooperativeKernel((const void*)fwd_mega, dim3(grid), dim3(512), args, LDS_BYTES, stream);
    if (e != hipSuccess) fprintf(stderr, "kernel_launch: cooperative launch failed: %s (grid %d)\n", hipGetErrorString(e), grid);
}
```
